# Optimizing an MI355X kernel written in HIP

```python
import jax, jax.numpy as jnp
from jax import lax
import numpy as np

D_MODEL = 1024
BATCH = 8
SEQ = 2048
DEPTH = 1

SSD_EXPAND = 2
D_INNER = SSD_EXPAND * D_MODEL
SSD_HEAD_DIM = 64
SSD_HEADS = D_INNER // SSD_HEAD_DIM
SSD_GROUPS = 4
SSD_HEADS_PER_GROUP = SSD_HEADS // SSD_GROUPS
D_STATE = 128
CONV_WIDTH = 4
CHUNK = 128
D_CONV = D_INNER + 2 * SSD_GROUPS * D_STATE

POOL_WIDTH = D_MODEL
POOL_WINDOWS = (2, 4, 8, 16)
POOL_GROUPS = len(POOL_WINDOWS)
POOL_GROUP_DIM = POOL_WIDTH // POOL_GROUPS

N_BRANCHES = 2
D_IN_PROJ = D_INNER + D_CONV + SSD_HEADS + POOL_WIDTH + N_BRANCHES * D_MODEL

N_EXPERTS = 32
TOP_K = 4
D_EXPERT = D_MODEL
SWIGLU_LIMIT = 7.0
SWIGLU_ALPHA = 1.702
MOE_BLOCK = 128

D_PLE = 256
EPS = 1e-6

kernel_name = "hybrid_ssd_pool_moe_block"


def rms_norm(x, g):
    xf = x.astype(jnp.float32)
    y = xf * lax.rsqrt(jnp.mean(xf * xf, axis=-1, keepdims=True) + EPS)
    return (y * g.astype(jnp.float32)).astype(x.dtype)


def causal_depthwise_conv(u, w, b):
    out = lax.conv_general_dilated(
        u, w[:, None, :], window_strides=(1,), padding=[(CONV_WIDTH - 1, 0)],
        dimension_numbers=("NWC", "WIO", "NWC"), feature_group_count=u.shape[-1])
    return out + b


def ssd_scan(xh, dt, a, bm, cm):
    bsz, seq = xh.shape[:2]
    nc = seq // CHUNK
    G, R, P, N = SSD_GROUPS, SSD_HEADS_PER_GROUP, SSD_HEAD_DIM, D_STATE
    xh = xh.astype(jnp.float32).reshape(bsz, nc, CHUNK, G, R, P)
    dt = dt.reshape(bsz, nc, CHUNK, G, R)
    bm = bm.astype(jnp.float32).reshape(bsz, nc, CHUNK, G, N)
    cm = cm.astype(jnp.float32).reshape(bsz, nc, CHUNK, G, N)
    xdt = xh * dt[..., None]
    a_cum = jnp.moveaxis(jnp.cumsum(dt * a, axis=2), 2, -1)
    causal = jnp.tril(jnp.ones((CHUNK, CHUNK), dtype=bool))
    seg = a_cum[..., :, None] - a_cum[..., None, :]
    decay = jnp.exp(jnp.where(causal, seg, -jnp.inf))
    cb = jnp.einsum("bclgn,bcsgn->bcgls", cm, bm)
    y_diag = jnp.einsum("bcgls,bcgrls,bcsgrp->bclgrp", cb, decay, xdt)
    decay_states = jnp.exp(a_cum[..., -1:] - a_cum)
    states = jnp.einsum("bclgn,bcgrl,bclgrp->bcgrpn", bm, decay_states, xdt)
    chunk_decay = jnp.exp(a_cum[..., -1])

    def step(h, inp):
        s_c, d_c = inp
        return h * d_c[..., None, None] + s_c, h

    h0 = jnp.zeros((bsz, G, R, P, N), jnp.float32)
    _, prev = lax.scan(step, h0, (jnp.moveaxis(states, 1, 0), jnp.moveaxis(chunk_decay, 1, 0)))
    prev = jnp.moveaxis(prev, 0, 1)
    y_off = jnp.einsum("bclgn,bcgrpn,bcgrl->bclgrp", cm, prev, jnp.exp(a_cum))
    return (y_diag + y_off).reshape(bsz, seq, G, R, P)


def ssd_branch(z, xbc, dt_raw, conv_w, conv_b, dt_bias, a_log, d_skip, norm_g, w_out):
    bsz, seq = z.shape[:2]
    G, R, P, N = SSD_GROUPS, SSD_HEADS_PER_GROUP, SSD_HEAD_DIM, D_STATE
    xbc = jax.nn.silu(causal_depthwise_conv(xbc, conv_w, conv_b))
    xs, bm, cm = jnp.split(xbc, [D_INNER, D_INNER + G * N], axis=-1)
    xh = xs.reshape(bsz, seq, G, R, P)
    bm = bm.reshape(bsz, seq, G, N)
    cm = cm.reshape(bsz, seq, G, N)
    dt = jax.nn.softplus(dt_raw.astype(jnp.float32) + dt_bias.astype(jnp.float32)).reshape(bsz, seq, G, R)
    a = -jnp.exp(a_log.astype(jnp.float32)).reshape(G, R)
    y = ssd_scan(xh, dt, a, bm, cm)
    y = y + d_skip.astype(jnp.float32).reshape(G, R)[..., None] * xh.astype(jnp.float32)
    y = y.reshape(bsz, seq, D_INNER) * jax.nn.silu(z.astype(jnp.float32))
    yg = y.reshape(bsz, seq, G, D_INNER // G)
    yg = yg * lax.rsqrt(jnp.mean(yg * yg, axis=-1, keepdims=True) + EPS)
    y = yg.reshape(bsz, seq, D_INNER) * norm_g.astype(jnp.float32)
    return y.astype(z.dtype) @ w_out


def pool_branch(u, w_group, scale):
    bsz, seq = u.shape[:2]
    uf = u.astype(jnp.float32).reshape(bsz, seq, POOL_GROUPS, POOL_GROUP_DIM)
    pos = jnp.arange(seq)
    outs = []
    for gi, w in enumerate(POOL_WINDOWS):
        ug = uf[:, :, gi]
        csum = jnp.cumsum(ug, axis=1)
        shifted = jnp.pad(csum, ((0, 0), (w, 0), (0, 0)))[:, :seq]
        count = jnp.minimum(pos + 1, w).astype(jnp.float32)[None, :, None]
        outs.append((csum - shifted) / count - ug)
    pooled = jnp.stack(outs, axis=2).astype(u.dtype)
    mixed = jnp.einsum("bsgi,gio->bsgo", pooled, w_group)
    return mixed.reshape(bsz, seq, POOL_WIDTH) * scale


def moe_ffn(h, w_router, b_router, w_gate_up, b_gate_up, w_down, b_down):
    bsz, seq, d = h.shape
    n_tok = bsz * seq
    hf = h.reshape(n_tok, d)
    logits = (hf @ w_router + b_router).astype(jnp.float32)
    top_val, top_idx = lax.top_k(logits, TOP_K)
    weights = jax.nn.softmax(top_val, axis=-1)
    n_assign = n_tok * TOP_K
    expert_flat = top_idx.reshape(-1).astype(jnp.int32)
    token_flat = jnp.arange(n_assign, dtype=jnp.int32) // TOP_K
    weight_flat = weights.reshape(-1)
    order = jnp.argsort(expert_flat)
    e_sorted = expert_flat[order]
    counts = jnp.bincount(expert_flat, length=N_EXPERTS).astype(jnp.int32)
    start = jnp.cumsum(counts) - counts
    padded = (counts + MOE_BLOCK - 1) // MOE_BLOCK * MOE_BLOCK
    pend = jnp.cumsum(padded)
    pstart = pend - padded
    rank = jnp.arange(n_assign, dtype=jnp.int32) - start[e_sorted]
    dest = pstart[e_sorted] + rank
    n_rows = n_assign + N_EXPERTS * MOE_BLOCK
    n_blocks = n_rows // MOE_BLOCK
    row_token = jnp.zeros((n_rows,), jnp.int32).at[dest].set(token_flat[order])
    row_weight = jnp.zeros((n_rows,), jnp.float32).at[dest].set(weight_flat[order])
    block_start = jnp.arange(n_blocks, dtype=jnp.int32) * MOE_BLOCK
    block_expert = jnp.minimum(jnp.sum(block_start[:, None] >= pend[None, :], axis=1), N_EXPERTS - 1)

    def expert_block(args):
        tok, e = args
        xb = hf[tok]
        gu = xb @ w_gate_up[e] + b_gate_up[e]
        gate, up = jnp.split(gu, 2, axis=-1)
        gate = jnp.minimum(gate, SWIGLU_LIMIT)
        up = jnp.clip(up, -SWIGLU_LIMIT, SWIGLU_LIMIT)
        act = (up + 1.0) * gate * jax.nn.sigmoid(SWIGLU_ALPHA * gate)
        return act @ w_down[e] + b_down[e]

    y_rows = lax.map(expert_block, (row_token.reshape(n_blocks, MOE_BLOCK), block_expert))
    y_rows = y_rows.reshape(n_rows, d).astype(jnp.float32) * row_weight[:, None]
    out = jnp.zeros((n_tok, d), jnp.float32).at[row_token].add(y_rows)
    return out.astype(h.dtype).reshape(bsz, seq, d)


def setup_inputs(seed: int = 0) -> dict:
    key = jax.random.key(seed)
    ks = jax.random.split(key, 32)
    f32 = jnp.float32
    nrm = lambda k, shape, s: jax.random.normal(k, shape, f32) * s
    gain = lambda k, shape: 1.0 + 0.02 * jax.random.normal(k, shape, f32)
    dt_init = jnp.exp(jax.random.uniform(ks[7], (DEPTH, SSD_HEADS), f32, np.log(1e-3), np.log(1e-1)))
    return {
        "x": nrm(ks[0], (BATCH, SEQ, D_MODEL), 1.0),
        "p": nrm(ks[1], (DEPTH, BATCH, SEQ, D_PLE), 1.0),
        "mix_norm_g": gain(ks[2], (DEPTH, D_MODEL)),
        "w_in": nrm(ks[3], (DEPTH, D_MODEL, D_IN_PROJ), D_MODEL ** -0.5),
        "conv_w": nrm(ks[4], (DEPTH, CONV_WIDTH, D_CONV), CONV_WIDTH ** -0.5),
        "conv_b": nrm(ks[5], (DEPTH, D_CONV), 0.02),
        "dt_bias": dt_init + jnp.log(-jnp.expm1(-dt_init)),
        "a_log": jnp.log(jax.random.uniform(ks[8], (DEPTH, SSD_HEADS), f32, 1.0, 16.0)),
        "d_skip": gain(ks[9], (DEPTH, SSD_HEADS)),
        "ssd_norm_g": gain(ks[10], (DEPTH, D_INNER)),
        "w_ssd_out": nrm(ks[11], (DEPTH, D_INNER, D_MODEL), D_INNER ** -0.5),
        "pool_w": nrm(ks[12], (DEPTH, POOL_GROUPS, POOL_GROUP_DIM, POOL_GROUP_DIM), POOL_GROUP_DIM ** -0.5),
        "pool_scale": gain(ks[13], (DEPTH, POOL_WIDTH)),
        "w_mix_out": nrm(ks[14], (DEPTH, D_MODEL, D_MODEL), D_MODEL ** -0.5),
        "ffn_norm_g": gain(ks[15], (DEPTH, D_MODEL)),
        "w_router": nrm(ks[16], (DEPTH, D_MODEL, N_EXPERTS), D_MODEL ** -0.5),
        "b_router": nrm(ks[17], (DEPTH, N_EXPERTS), 0.01),
        "w_gate_up": nrm(ks[18], (DEPTH, N_EXPERTS, D_MODEL, 2 * D_EXPERT), D_MODEL ** -0.5),
        "b_gate_up": nrm(ks[19], (DEPTH, N_EXPERTS, 2 * D_EXPERT), 0.02),
        "w_down": nrm(ks[20], (DEPTH, N_EXPERTS, D_EXPERT, D_MODEL), D_EXPERT ** -0.5),
        "b_down": nrm(ks[21], (DEPTH, N_EXPERTS, D_MODEL), 0.02),
        "ple_norm_g": gain(ks[22], (DEPTH, D_MODEL)),
        "w_ple_gate": nrm(ks[23], (DEPTH, D_MODEL, D_MODEL), D_MODEL ** -0.5),
        "w_ple_proj": nrm(ks[24], (DEPTH, D_PLE, D_MODEL), D_PLE ** -0.5),
        "final_norm_g": gain(ks[25], (D_MODEL,)),
    }


def reference(x, p, mix_norm_g, w_in, conv_w, conv_b, dt_bias, a_log, d_skip, ssd_norm_g,
              w_ssd_out, pool_w, pool_scale, w_mix_out, ffn_norm_g, w_router, b_router,
              w_gate_up, b_gate_up, w_down, b_down, ple_norm_g, w_ple_gate, w_ple_proj,
              final_norm_g):
    split_at = [D_INNER, D_INNER + D_CONV, D_INNER + D_CONV + SSD_HEADS,
                D_INNER + D_CONV + SSD_HEADS + POOL_WIDTH]
    for i in range(DEPTH):
        h = rms_norm(x, mix_norm_g[i])
        proj = h @ w_in[i]
        z, xbc, dt_raw, u, gates = jnp.split(proj, split_at, axis=-1)
        y_ssd = ssd_branch(z, xbc, dt_raw, conv_w[i], conv_b[i], dt_bias[i], a_log[i],
                           d_skip[i], ssd_norm_g[i], w_ssd_out[i])
        y_pool = pool_branch(u, pool_w[i], pool_scale[i])
        g_ssd, g_pool = jnp.split(jax.nn.sigmoid(gates), N_BRANCHES, axis=-1)
        x = x + (g_ssd * y_ssd + g_pool * y_pool) @ w_mix_out[i]
        h = rms_norm(x, ffn_norm_g[i])
        x = x + moe_ffn(h, w_router[i], b_router[i], w_gate_up[i], b_gate_up[i], w_down[i], b_down[i])
        ple_gate = jax.nn.sigmoid(rms_norm(x, ple_norm_g[i]) @ w_ple_gate[i])
        x = x + ple_gate * (p[i] @ w_ple_proj[i])
    return rms_norm(x, final_norm_g)
```

```cpp
#include <hip/hip_runtime.h>
#include <cstdio>
#include <cstdint>
#include <cstring>

namespace {
constexpr int T = 16384, SEQ = 2048, NB = 8, D = 1024;
constexpr int DIN = 2048, NH = 32, HP = 64, NG = 4, NS = 128, DCONV = 3072;
constexpr int NPROJ = 8224;
constexpr int C_Z = 0, C_XBC = 2048, C_DT = 5120, C_U = 5152, C_GS = 6176, C_GP = 7200;
constexpr int NE = 32, TOPK = 4, DE = 1024, DPLE = 256;
constexpr int NA = T * TOPK;
constexpr int RT = 64;
constexpr int MAXROWS = NA + NE * RT;
constexpr int MAXTILES = MAXROWS / RT;
constexpr float EPS = 1e-6f;
constexpr size_t MB = 1u << 20;
constexpr size_t WS_R0 = 0;
constexpr size_t WS_Y = 560 * MB;
constexpr size_t WS_YSSD = 694 * MB;
constexpr size_t WS_POOLED = 761 * MB;
constexpr size_t WS_YPOOL = 828 * MB;
constexpr size_t WS_XN = 895 * MB;
constexpr size_t WS_SMALL = 962 * MB;
constexpr size_t WS_YROWS = 560 * MB;
constexpr size_t WS_END = 975 * MB;

__device__ __forceinline__ float wave_sum(float v) {
#pragma unroll
    for (int o = 1; o < 64; o <<= 1) v += __shfl_xor(v, o);
    return v;
}
__device__ __forceinline__ float sigmoidf_(float x) { return 1.f / (1.f + __expf(-x)); }
__device__ __forceinline__ float siluf_(float x) { return x / (1.f + __expf(-x)); }

__global__ void __launch_bounds__(256) k_rmsnorm(const float* x, const float* g, float* out, int rows) {
    const int w = (blockIdx.x * 256 + threadIdx.x) >> 6, lane = threadIdx.x & 63;
    if (w >= rows) return;
    const float4* xr = (const float4*)(x + (size_t)w * D);
    float4 v[4]; float s = 0.f;
#pragma unroll
    for (int j = 0; j < 4; ++j) { v[j] = xr[lane + 64 * j]; s += v[j].x * v[j].x + v[j].y * v[j].y + v[j].z * v[j].z + v[j].w * v[j].w; }
    s = wave_sum(s);
    const float r = rsqrtf(s * (1.f / D) + EPS);
    float4* o = (float4*)(out + (size_t)w * D);
#pragma unroll
    for (int j = 0; j < 4; ++j) { const float4 gg = ((const float4*)g)[lane + 64 * j]; o[lane + 64 * j] = make_float4(v[j].x * r * gg.x, v[j].y * r * gg.y, v[j].z * r * gg.z, v[j].w * r * gg.w); }
}

struct GemmP {
    const float* A; int lda; const float* B; int ldb; float* C; int ldc; int M, N, K;
    const float* bias; const int* gather; const int* tile_expert; size_t strideB; size_t strideBias; const int* nrows_dyn;
};
__global__ void __launch_bounds__(256) k_gemm(GemmP p) {
    __shared__ float As[16][64 + 4];
    __shared__ float Bs[16][64 + 4];
    const int tid = threadIdx.x, tx = tid & 15, ty = tid >> 4;
    const int row0 = blockIdx.y * 64, col0 = blockIdx.x * 64;
    int M = p.M; if (p.nrows_dyn) M = *p.nrows_dyn;
    if (row0 >= M) return;
    const float* B = p.B; const float* bias = p.bias;
    if (p.tile_expert) { const int e = p.tile_expert[blockIdx.y]; B += (size_t)e * p.strideB; if (bias) bias += (size_t)e * p.strideBias; }
    float acc[4][4] = {};
    const int ar = tid >> 2, ak = (tid & 3) * 4;
    int arow = row0 + ar; long asrc = -1;
    if (arow < M) { asrc = arow; if (p.gather) asrc = p.gather[arow]; }
    const int bk = tid >> 4, bc = (tid & 15) * 4;
    const bool bok = (col0 + bc) < p.N;
    for (int k0 = 0; k0 < p.K; k0 += 16) {
        float4 av = make_float4(0.f, 0.f, 0.f, 0.f);
        if (asrc >= 0) av = *(const float4*)(p.A + (size_t)asrc * p.lda + k0 + ak);
        float4 bv = make_float4(0.f, 0.f, 0.f, 0.f);
        if (bok) bv = *(const float4*)(B + (size_t)(k0 + bk) * p.ldb + col0 + bc);
        As[ak + 0][ar] = av.x; As[ak + 1][ar] = av.y; As[ak + 2][ar] = av.z; As[ak + 3][ar] = av.w;
        *(float4*)&Bs[bk][bc] = bv;
        __syncthreads();
#pragma unroll
        for (int k = 0; k < 16; ++k) {
            const float4 a = *(const float4*)&As[k][ty * 4];
            const float4 b = *(const float4*)&Bs[k][tx * 4];
            const float aa[4] = {a.x, a.y, a.z, a.w}, bb[4] = {b.x, b.y, b.z, b.w};
#pragma unroll
            for (int i = 0; i < 4; ++i)
#pragma unroll
                for (int j = 0; j < 4; ++j) acc[i][j] = fmaf(aa[i], bb[j], acc[i][j]);
        }
        __syncthreads();
    }
    const int c = col0 + tx * 4;
    if (c < p.N) {
        float4 bv = make_float4(0.f, 0.f, 0.f, 0.f);
        if (bias) bv = *(const float4*)(bias + c);
#pragma unroll
        for (int i = 0; i < 4; ++i) { const int r = row0 + ty * 4 + i; if (r < M) *(float4*)(p.C + (size_t)r * p.ldc + c) = make_float4(acc[i][0] + bv.x, acc[i][1] + bv.y, acc[i][2] + bv.z, acc[i][3] + bv.w); }
    }
}

__global__ void __launch_bounds__(512) k_ssd(const float* __restrict__ proj, const float* __restrict__ conv_w, const float* __restrict__ conv_b, const float* __restrict__ dt_bias,
                                              const float* __restrict__ a_log, const float* __restrict__ d_skip, float* __restrict__ Y) {
    __shared__ float sx[2][64], sB[2][128], sC[2][128];
    const int b = blockIdx.x / NH, h = blockIdx.x % NH, g = h / 8, tid = threadIdx.x, p = tid >> 3, nb = tid & 7;
    int cch = -1;
    if (tid < 64) cch = h * 64 + tid; else if (tid < 192) cch = 2048 + g * 128 + (tid - 64); else if (tid < 320) cch = 2560 + g * 128 + (tid - 192);
    float w0 = 0, w1 = 0, w2 = 0, w3 = 0, cb = 0;
    if (cch >= 0) { w0 = conv_w[0 * DCONV + cch]; w1 = conv_w[1 * DCONV + cch]; w2 = conv_w[2 * DCONV + cch]; w3 = conv_w[3 * DCONV + cch]; cb = conv_b[cch]; }
    const float a = -__expf(a_log[h]), dsk = d_skip[h], dtb = dt_bias[h];
    float st[16];
#pragma unroll
    for (int i = 0; i < 16; ++i) st[i] = 0.f;
    float x1 = 0.f, x2 = 0.f, x3 = 0.f;
    for (int t = 0; t < SEQ; ++t) {
        const size_t row = (size_t)(b * SEQ + t) * NPROJ;
        const int buf = t & 1;
        if (cch >= 0) {
            const float x0 = proj[row + C_XBC + cch];
            float v = cb + w3 * x0 + w2 * x1 + w1 * x2 + w0 * x3;
            x3 = x2; x2 = x1; x1 = x0;
            v = siluf_(v);
            if (tid < 64) sx[buf][tid] = v; else if (tid < 192) sB[buf][tid - 64] = v; else sC[buf][tid - 192] = v;
        }
        const float dtr = proj[row + C_DT + h] + dtb;
        const float dt = dtr > 20.f ? dtr : log1pf(__expf(dtr));
        const float dA = __expf(dt * a);
        __syncthreads();
        const float xv = sx[buf][p];
        const float dx = dt * xv;
        float y = 0.f;
#pragma unroll
        for (int i = 0; i < 16; ++i) { st[i] = st[i] * dA + dx * sB[buf][nb * 16 + i]; y = fmaf(sC[buf][nb * 16 + i], st[i], y); }
        y += __shfl_xor(y, 1); y += __shfl_xor(y, 2); y += __shfl_xor(y, 4);
        if (nb == 0) Y[(size_t)(b * SEQ + t) * DIN + h * 64 + p] = y + dsk * xv;
    }
}

__global__ void __launch_bounds__(256) k_gate_norm(float* __restrict__ Y, const float* __restrict__ proj, const float* __restrict__ norm_g) {
    const int w = (blockIdx.x * 256 + threadIdx.x) >> 6, lane = threadIdx.x & 63;
    if (w >= T * NG) return;
    const int t = w >> 2, g = w & 3;
    float* yr = Y + (size_t)t * DIN + g * 512;
    const float* zr = proj + (size_t)t * NPROJ + C_Z + g * 512;
    float v[8]; float s = 0.f;
#pragma unroll
    for (int j = 0; j < 2; ++j) { const float4 a = ((const float4*)yr)[lane + 64 * j], z = ((const float4*)zr)[lane + 64 * j];
        v[4 * j + 0] = a.x * siluf_(z.x); v[4 * j + 1] = a.y * siluf_(z.y); v[4 * j + 2] = a.z * siluf_(z.z); v[4 * j + 3] = a.w * siluf_(z.w); }
#pragma unroll
    for (int i = 0; i < 8; ++i) s += v[i] * v[i];
    s = wave_sum(s);
    const float r = rsqrtf(s * (1.f / 512.f) + EPS);
#pragma unroll
    for (int j = 0; j < 2; ++j) { const float4 gg = ((const float4*)(norm_g + g * 512))[lane + 64 * j];
        ((float4*)yr)[lane + 64 * j] = make_float4(v[4 * j] * r * gg.x, v[4 * j + 1] * r * gg.y, v[4 * j + 2] * r * gg.z, v[4 * j + 3] * r * gg.w); }
}

__global__ void __launch_bounds__(256) k_pool(const float* __restrict__ proj, float* __restrict__ pooled) {
    const size_t i = (size_t)blockIdx.x * 256 + threadIdx.x;
    const int t = (int)(i >> 10), c = (int)(i & 1023), gi = c >> 8, w = 2 << gi, pos = t % SEQ;
    const int cnt = (pos + 1 < w) ? pos + 1 : w;
    float s = 0.f;
    for (int j = 0; j < cnt; ++j) s += proj[(size_t)(t - j) * NPROJ + C_U + c];
    pooled[i] = s / (float)cnt - proj[(size_t)t * NPROJ + C_U + c];
}
__global__ void __launch_bounds__(256) k_mix(float* __restrict__ yssd, const float* __restrict__ ypool, const float* __restrict__ proj, const float* __restrict__ scale) {
    const size_t i = (size_t)blockIdx.x * 256 + threadIdx.x;
    const int t = (int)(i >> 10), c = (int)(i & 1023);
    const float gs = sigmoidf_(proj[(size_t)t * NPROJ + C_GS + c]), gp = sigmoidf_(proj[(size_t)t * NPROJ + C_GP + c]);
    yssd[i] = gs * yssd[i] + gp * ypool[i] * scale[c];
}
__global__ void __launch_bounds__(256) k_add(float* __restrict__ out, const float* __restrict__ a, const float* __restrict__ b) {
    const size_t i = (size_t)blockIdx.x * 256 + threadIdx.x; out[i] = a[i] + b[i];
}
__global__ void __launch_bounds__(256) k_topk(const float* __restrict__ logits, const float* __restrict__ b_router, int* __restrict__ tidx, float* __restrict__ tw) {
    const int t = blockIdx.x * 256 + threadIdx.x; if (t >= T) return;
    float v[32];
#pragma unroll
    for (int e = 0; e < 32; ++e) v[e] = logits[(size_t)t * 32 + e] + b_router[e];
    float tv[4]; int ti[4];
#pragma unroll
    for (int k = 0; k < 4; ++k) { float best = -INFINITY; int bi = 0;
#pragma unroll
        for (int e = 0; e < 32; ++e) { if (v[e] > best) { best = v[e]; bi = e; } }
        tv[k] = best; ti[k] = bi;
#pragma unroll
        for (int e = 0; e < 32; ++e) if (e == bi) v[e] = -INFINITY; }
    float s = 0.f, ex[4];
#pragma unroll
    for (int k = 0; k < 4; ++k) { ex[k] = __expf(tv[k] - tv[0]); s += ex[k]; }
#pragma unroll
    for (int k = 0; k < 4; ++k) { tidx[t * 4 + k] = ti[k]; tw[t * 4 + k] = ex[k] / s; }
}
__global__ void __launch_bounds__(256) k_route(const int* __restrict__ tidx, int* __restrict__ row_token, int* __restrict__ dest, int* __restrict__ tile_expert, int* __restrict__ nrows) {
    __shared__ int cnt[32], pstart[33];
    const int tid = threadIdx.x;
    if (tid < 32) cnt[tid] = 0;
    for (int i = tid; i < MAXROWS; i += 256) row_token[i] = -1;
    __syncthreads();
#pragma unroll 1
    for (int a = tid; a < NA; a += 256) { const int e = tidx[a]; dest[a] = atomicAdd(&cnt[e], 1); }
    __syncthreads();
    if (tid == 0) { int s = 0; for (int e = 0; e < 32; ++e) { pstart[e] = s; s += (cnt[e] + RT - 1) / RT * RT; } pstart[32] = s; *nrows = s; }
    __syncthreads();
#pragma unroll 1
    for (int a = tid; a < NA; a += 256) { const int e = tidx[a]; const int d = pstart[e] + dest[a]; dest[a] = d; row_token[d] = a >> 2; }
#pragma unroll 1
    for (int tl = tid; tl < MAXTILES; tl += 256) { const int r = tl * RT; int e = 0;
#pragma unroll 1
        for (int q = 0; q < 32; ++q) if (r >= pstart[q + 1]) e = q + 1;
        tile_expert[tl] = e > 31 ? 31 : e; }
}
__global__ void __launch_bounds__(256) k_act(float* __restrict__ gu, const int* __restrict__ nrows) {
    const size_t i = (size_t)blockIdx.x * 256 + threadIdx.x;
    const int r = (int)(i >> 10), j = (int)(i & 1023);
    if (r >= *nrows) return;
    float gate = gu[(size_t)r * 2048 + j], up = gu[(size_t)r * 2048 + 1024 + j];
    gate = fminf(gate, 7.f); up = fminf(fmaxf(up, -7.f), 7.f);
    gu[(size_t)r * 2048 + j] = (up + 1.f) * gate * sigmoidf_(1.702f * gate);
}
__global__ void __launch_bounds__(256) k_combine(float* __restrict__ x, const float* __restrict__ yrows, const int* __restrict__ dest, const float* __restrict__ tw) {
    const size_t i = (size_t)blockIdx.x * 256 + threadIdx.x;
    const int t = (int)(i >> 10), c = (int)(i & 1023);
    float s = 0.f;
#pragma unroll
    for (int k = 0; k < 4; ++k) s += tw[t * 4 + k] * yrows[(size_t)dest[t * 4 + k] * 1024 + c];
    x[i] += s;
}
__global__ void __launch_bounds__(256) k_ple(float* __restrict__ x, const float* __restrict__ gate, const float* __restrict__ proj) {
    const size_t i = (size_t)blockIdx.x * 256 + threadIdx.x;
    x[i] += sigmoidf_(gate[i]) * proj[i];
}

void gemm(hipStream_t s, const float* A, int lda, const float* B, int ldb, float* C, int ldc, int M, int N, int K, const float* bias = nullptr,
          const int* gather = nullptr, const int* tile_expert = nullptr, size_t strideB = 0, size_t strideBias = 0, const int* nrows_dyn = nullptr) {
    GemmP p; memset(&p, 0, sizeof(p)); p.A = A; p.lda = lda; p.B = B; p.ldb = ldb; p.C = C; p.ldc = ldc; p.M = M; p.N = N; p.K = K; p.bias = bias; p.gather = gather; p.tile_expert = tile_expert;
    p.strideB = strideB; p.strideBias = strideBias; p.nrows_dyn = nrows_dyn;
    dim3 grid((N + 63) / 64, (M + 63) / 64);
    hipLaunchKernelGGL(k_gemm, grid, dim3(256), 0, s, p);
}
}

extern "C" void kernel_launch(void* const* d_in, const int* in_sizes, int n_in, void* d_out, int out_size, void* d_ws, size_t ws_size, hipStream_t stream) {
    if (n_in != 25 || out_size != T * D || ws_size < WS_END) { fprintf(stderr, "kernel_launch: unexpected shapes (n_in %d out %d ws %zu)\n", n_in, out_size, ws_size); return; }
    const float* x = (const float*)d_in[0]; const float* pp = (const float*)d_in[1]; const float* mix_norm_g = (const float*)d_in[2]; const float* w_in = (const float*)d_in[3];
    const float* conv_w = (const float*)d_in[4]; const float* conv_b = (const float*)d_in[5]; const float* dt_bias = (const float*)d_in[6]; const float* a_log = (const float*)d_in[7];
    const float* d_skip = (const float*)d_in[8]; const float* ssd_norm_g = (const float*)d_in[9]; const float* w_ssd_out = (const float*)d_in[10]; const float* pool_w = (const float*)d_in[11];
    const float* pool_scale = (const float*)d_in[12]; const float* w_mix_out = (const float*)d_in[13]; const float* ffn_norm_g = (const float*)d_in[14]; const float* w_router = (const float*)d_in[15];
    const float* b_router = (const float*)d_in[16]; const float* w_gate_up = (const float*)d_in[17]; const float* b_gate_up = (const float*)d_in[18]; const float* w_down = (const float*)d_in[19];
    const float* b_down = (const float*)d_in[20]; const float* ple_norm_g = (const float*)d_in[21]; const float* w_ple_gate = (const float*)d_in[22]; const float* w_ple_proj = (const float*)d_in[23];
    const float* final_norm_g = (const float*)d_in[24];
    char* ws = (char*)d_ws; float* out = (float*)d_out;
    float* PROJ = (float*)(ws + WS_R0); float* GU = (float*)(ws + WS_R0); float* Y = (float*)(ws + WS_Y); float* YSSD = (float*)(ws + WS_YSSD);
    float* POOLED = (float*)(ws + WS_POOLED); float* YPOOL = (float*)(ws + WS_YPOOL); float* XN = (float*)(ws + WS_XN); float* YROWS = (float*)(ws + WS_YROWS);
    char* sm = ws + WS_SMALL;
    float* LOGITS = (float*)sm; sm += (size_t)T * 32 * 4;
    int* TIDX = (int*)sm; sm += (size_t)NA * 4; float* TW = (float*)sm; sm += (size_t)NA * 4; int* DEST = (int*)sm; sm += (size_t)NA * 4;
    int* ROWTOK = (int*)sm; sm += (size_t)MAXROWS * 4; int* TEXP = (int*)sm; sm += (size_t)MAXTILES * 4; int* NROWS = (int*)sm; sm += 256;
    const int EW = T * D / 256;
    hipLaunchKernelGGL(k_rmsnorm, dim3(T / 4), dim3(256), 0, stream, x, mix_norm_g, XN, T);
    gemm(stream, XN, D, w_in, NPROJ, PROJ, NPROJ, T, NPROJ, D);
    hipLaunchKernelGGL(k_ssd, dim3(NB * NH), dim3(512), 0, stream, PROJ, conv_w, conv_b, dt_bias, a_log, d_skip, Y);
    hipLaunchKernelGGL(k_gate_norm, dim3(T * NG / 4), dim3(256), 0, stream, Y, PROJ, ssd_norm_g);
    gemm(stream, Y, DIN, w_ssd_out, D, YSSD, D, T, D, DIN);
    hipLaunchKernelGGL(k_pool, dim3(EW), dim3(256), 0, stream, PROJ, POOLED);
    for (int g = 0; g < 4; ++g) gemm(stream, POOLED + g * 256, D, pool_w + (size_t)g * 256 * 256, 256, YPOOL + g * 256, D, T, 256, 256);
    hipLaunchKernelGGL(k_mix, dim3(EW), dim3(256), 0, stream, YSSD, YPOOL, PROJ, pool_scale);
    gemm(stream, YSSD, D, w_mix_out, D, POOLED, D, T, D, D);
    hipLaunchKernelGGL(k_add, dim3(EW), dim3(256), 0, stream, out, x, POOLED);
    hipLaunchKernelGGL(k_rmsnorm, dim3(T / 4), dim3(256), 0, stream, out, ffn_norm_g, XN, T);
    gemm(stream, XN, D, w_router, NE, LOGITS, NE, T, NE, D);
    hipLaunchKernelGGL(k_topk, dim3(T / 256), dim3(256), 0, stream, LOGITS, b_router, TIDX, TW);
    hipLaunchKernelGGL(k_route, dim3(1), dim3(256), 0, stream, TIDX, ROWTOK, DEST, TEXP, NROWS);
    gemm(stream, XN, D, w_gate_up, 2 * DE, GU, 2 * DE, MAXROWS, 2 * DE, D, b_gate_up, ROWTOK, TEXP, (size_t)D * 2 * DE, (size_t)2 * DE, NROWS);
    hipLaunchKernelGGL(k_act, dim3(MAXROWS * 1024 / 256), dim3(256), 0, stream, GU, NROWS);
    gemm(stream, GU, 2 * DE, w_down, D, YROWS, D, MAXROWS, D, DE, b_down, nullptr, TEXP, (size_t)DE * D, (size_t)D, NROWS);
    hipLaunchKernelGGL(k_combine, dim3(EW), dim3(256), 0, stream, out, YROWS, DEST, TW);
    hipLaunchKernelGGL(k_rmsnorm, dim3(T / 4), dim3(256), 0, stream, out, ple_norm_g, XN, T);
    gemm(stream, XN, D, w_ple_gate, D, (float*)(ws + WS_Y), D, T, D, D);
    gemm(stream, pp, DPLE, w_ple_proj, D, (float*)(ws + WS_Y) + (size_t)T * D, D, T, D, DPLE);
    hipLaunchKernelGGL(k_ple, dim3(EW), dim3(256), 0, stream, out, (const float*)(ws + WS_Y), (const float*)(ws + WS_Y) + (size_t)T * D);
    hipLaunchKernelGGL(k_rmsnorm, dim3(T / 4), dim3(256), 0, stream, out, final_norm_g, out, T);
}
```

```cpp
#include <hip/hip_runtime.h>
#include <cstdio>
#include <cstdint>
#include <cstring>

#ifndef MK_MULTI
#define MK_MULTI 0
#endif

#define LAS __attribute__((address_space(3)))
#define GAS __attribute__((address_space(1)))
typedef unsigned short bf16;
typedef short bf16x8 __attribute__((ext_vector_type(8)));
typedef float f32x4 __attribute__((ext_vector_type(4)));
typedef unsigned u32x4 __attribute__((ext_vector_type(4)));
typedef unsigned u32x2 __attribute__((ext_vector_type(2)));

namespace {
constexpr int T = 16384, SEQ = 2048, NB = 8, D = 1024;
constexpr int DIN = 2048, NH = 32, DCONV = 3072, NPROJ = 8224;
constexpr int NE = 32, DE = 1024, DPLE = 256;
constexpr int NA = T * 4;
constexpr int MAXROWS = NA + NE * 256;
constexpr float EPS = 1e-6f;
constexpr int NWAVES = 8, NTHREADS = 512;
constexpr int NPH = 13;
constexpr size_t MiB = 1u << 20;
constexpr size_t WS_CTL = 0, CTL_ZERO_BYTES = 1 * MiB;
constexpr size_t WS_WIN = 2 * MiB, WS_WOUT = 18 * MiB, WS_WPOOL = 22 * MiB, WS_WMIX = 23 * MiB, WS_WPG = 25 * MiB, WS_WPP = 27 * MiB;
constexpr size_t WS_WGU = 28 * MiB, WS_WDN = 156 * MiB;
constexpr size_t WS_XN = 220 * MiB, WS_DT = 252 * MiB, WS_SS = 254 * MiB, WS_RSTD = 256 * MiB, WS_PO = 257 * MiB, WS_YPG = 289 * MiB, WS_MIXED = 321 * MiB, WS_PB = 353 * MiB;
constexpr size_t WS_ROUTE = 361 * MiB;
constexpr size_t WS_Z = 364 * MiB, WS_XBC = 428 * MiB, WS_U = 524 * MiB, WS_GT = 556 * MiB, WS_V = 620 * MiB;
constexpr size_t WS_ACT = 364 * MiB, WS_YR = 508 * MiB;
constexpr size_t WS_TMP = 684 * MiB, WS_END = 748 * MiB;
constexpr int CW_BAR = 4096;

__device__ __forceinline__ float bf2f(unsigned v) { return __uint_as_float(v << 16); }
__device__ __forceinline__ unsigned f2bf(float f) { unsigned u = __float_as_uint(f); return (u + 0x7fffu + ((u >> 16) & 1u)) >> 16; }
__device__ __forceinline__ unsigned pk2(float lo, float hi) { unsigned r; asm volatile("v_cvt_pk_bf16_f32 %0, %1, %2" : "=v"(r) : "v"(lo), "v"(hi)); return r; }
__device__ __forceinline__ float wave_sum(float v) {
#pragma unroll
    for (int o = 1; o < 64; o <<= 1) v += __shfl_xor(v, o);
    return v;
}
__device__ __forceinline__ float sigmoidf_(float x) { return 1.f / (1.f + __expf(-x)); }
__device__ __forceinline__ float siluf_(float x) { return x / (1.f + __expf(-x)); }
__device__ __forceinline__ void unpack8(const u32x4 w, float (&f)[8]) {
    f[0] = bf2f(w.x & 0xffffu); f[1] = bf2f(w.x >> 16); f[2] = bf2f(w.y & 0xffffu); f[3] = bf2f(w.y >> 16);
    f[4] = bf2f(w.z & 0xffffu); f[5] = bf2f(w.z >> 16); f[6] = bf2f(w.w & 0xffffu); f[7] = bf2f(w.w >> 16);
}
__device__ __forceinline__ u32x4 pack8(const f32x4 lo, const f32x4 hi) { u32x4 w; w.x = pk2(lo[0], lo[1]); w.y = pk2(lo[2], lo[3]); w.z = pk2(hi[0], hi[1]); w.w = pk2(hi[2], hi[3]); return w; }
__host__ __device__ __forceinline__ int perm32(int rho) { const int n = rho >> 4, i = rho & 15; return 8 * (i >> 2) + 4 * n + (i & 3); }

#define XB_TMO      128
#define XB_XCNT(j)  (256  + 64 * (j))
#define XB_XSUB(j)  (1280 + 64 * (j))
#define XB_XGEN(j)  (2304 + 64 * (j))
#define XB_TOP      3328
#define XB_TOPGEN   3392
#define XCD_BAR_WORDS 3456
#define XB_SPIN_CAP (1u << 18)
__device__ __forceinline__ unsigned xb_ld(unsigned* p)              { return __hip_atomic_load(p, __ATOMIC_RELAXED, __HIP_MEMORY_SCOPE_AGENT); }
__device__ __forceinline__ unsigned xb_add(unsigned* p, unsigned v) { return __hip_atomic_fetch_add(p, v, __ATOMIC_RELAXED, __HIP_MEMORY_SCOPE_AGENT); }
__device__ __forceinline__ unsigned xb_xcc_id() { return (unsigned)__builtin_amdgcn_s_getreg((3 << 11) | 20) & 0xFu; }
#define XB_SPIN(cond, bar) do { unsigned _sp = 0; while (cond) { __builtin_amdgcn_s_sleep(1); \
    if ((++_sp & 255u) == 0u) { if (xb_ld(&(bar)[XB_TMO])) break; if (_sp > XB_SPIN_CAP) { atomicAdd(&(bar)[XB_TMO], 1u); break; } } } } while (0)
struct XcdBarrier { unsigned* bar; unsigned x; volatile LAS unsigned* st; };
__device__ __forceinline__ XcdBarrier xcd_barrier_post(unsigned* bar, volatile LAS unsigned* st) {
    XcdBarrier b; b.bar = bar; b.x = xb_xcc_id(); b.st = st;
    if (threadIdx.x == 0) (void)xb_add(&bar[XB_XCNT(b.x)], 1u);
    return b;
}
__device__ __forceinline__ void xcd_barrier_complete(unsigned* bar, unsigned x, unsigned& nloc, unsigned& nx) {
    const unsigned G = gridDim.x * gridDim.y * gridDim.z;
    unsigned sum, cnt, mine, sp = 0u;
    for (;;) {
        sum = 0u; cnt = 0u; mine = 0u;
#pragma unroll
        for (unsigned j = 0; j < 16; ++j) { const unsigned c = xb_ld(&bar[XB_XCNT(j)]); sum += c; cnt += (c > 0u) ? 1u : 0u; mine = (j == x) ? c : mine; }
        if (sum == G) break;
        __builtin_amdgcn_s_sleep(1);
        if ((++sp & 255u) == 0u) { if (xb_ld(&bar[XB_TMO])) break; if (sp > XB_SPIN_CAP) { atomicAdd(&bar[XB_TMO], 1u); break; } }
    }
    nloc = mine > 0u ? mine : 1u; nx = cnt > 0u ? cnt : 1u;
}
__device__ __forceinline__ void xcd_barrier(const XcdBarrier& b) {
    asm volatile("s_waitcnt vmcnt(0)" ::: "memory");
    __syncthreads();
    if (threadIdx.x == 0) {
        unsigned* bar = b.bar;
        __builtin_amdgcn_s_waitcnt(0);
        unsigned nloc = b.st[0], nx = b.st[1];
        if (nloc == 0u) { xcd_barrier_complete(bar, b.x, nloc, nx); b.st[0] = nloc; b.st[1] = nx; }
        const unsigned old = xb_add(&bar[XB_XSUB(b.x)], 1u);
        const unsigned gen = old / nloc;
        if (old + 1u == (gen + 1u) * nloc) {
            __builtin_amdgcn_fence(__ATOMIC_RELEASE, "agent");
            asm volatile("s_waitcnt vmcnt(0)" ::: "memory");
            const unsigned og = xb_add(&bar[XB_TOP], 1u);
            const unsigned tg = og / nx;
            if (og + 1u == (tg + 1u) * nx) xb_add(&bar[XB_TOPGEN], 1u);
            else XB_SPIN(xb_ld(&bar[XB_TOPGEN]) == tg, bar);
            __builtin_amdgcn_fence(__ATOMIC_ACQUIRE, "agent");
            xb_add(&bar[XB_XGEN(b.x)], 1u);
            asm volatile("s_waitcnt vmcnt(0)" ::: "memory");
        } else {
            XB_SPIN(xb_ld(&bar[XB_XGEN(b.x)]) == gen, bar);
            __builtin_amdgcn_fence(__ATOMIC_ACQUIRE, "agent");
            asm volatile("s_waitcnt vmcnt(0)" ::: "memory");
        }
    }
    __syncthreads();
}

struct Args { const float* in[25]; float* out; unsigned char* ws; int ph_lo, ph_hi; };
struct Frame {
    LAS unsigned char* lds; int tid, lane, wave, G, wg;
    const float *x, *p, *mix_norm_g, *w_in, *conv_w, *conv_b, *dt_bias, *a_log, *d_skip, *ssd_norm_g, *w_ssd_out, *pool_w, *pool_scale, *w_mix_out, *ffn_norm_g, *w_router, *b_router,
        *w_gate_up, *b_gate_up, *w_down, *b_down, *ple_norm_g, *w_ple_gate, *w_ple_proj, *final_norm_g;
    float* out;
    bf16 *WIN, *WOUT, *WPOOL, *WMIX, *WPG, *WPP, *WGU, *WDN;
    bf16 *XN, *PO, *YPG, *MIXED, *PB, *Z, *XBC, *U, *GT, *V, *ACT, *YR;
    float *DT, *SS, *RSTD, *TMP;
    int *TIDX, *DEST, *ROWTOK, *CNT, *PSTART; float* TW;
};

struct GUnit { int pm, pn, e; const bf16* a; const bf16* bt; };
struct NoHook { static constexpr bool ON = false; __device__ __forceinline__ float ratio(int, int) const { return 1.f; } };
struct RstdHook { static constexpr bool ON = true; const float* rstd;
    __device__ __forceinline__ float ratio(int row, int g) const { const float r = rstd[row * 4 + g]; return g < 3 ? r / rstd[row * 4 + g + 1] : r; } };

template <class Epi, class Hook>
__device__ __forceinline__ void sgemm_unit(const GUnit& u, int lda, int K, const int* gather, const Epi& E, const Hook& H, int wave, int lane) {
    const int wr = wave >> 2, wc = wave & 3, fr = lane & 15, fq = lane >> 4;
#pragma unroll 1
    for (int ai = 0; ai < 2; ++ai) {
        f32x4 acc[2][4][2];
#pragma unroll
        for (int bj = 0; bj < 2; ++bj)
#pragma unroll
            for (int m = 0; m < 4; ++m)
#pragma unroll
                for (int n = 0; n < 2; ++n) acc[bj][m][n] = (f32x4){0.f, 0.f, 0.f, 0.f};
        const bf16* ap[4]; const bf16* bp[2][2];
#pragma unroll
        for (int m = 0; m < 4; ++m) { const int row = u.pm * 256 + ai * 128 + wr * 64 + m * 16 + fr; const int src = gather ? gather[row] : row; ap[m] = u.a + (size_t)src * lda + 8 * fq; }
#pragma unroll
        for (int bj = 0; bj < 2; ++bj)
#pragma unroll
            for (int n = 0; n < 2; ++n) bp[bj][n] = u.bt + (size_t)(u.pn * 256 + bj * 128 + wc * 32 + perm32(n * 16 + fr)) * K + 8 * fq;
#pragma unroll 1
        for (int k0 = 0; k0 < K; k0 += 32) {
            bf16x8 af[4], bf[2][2];
#pragma unroll
            for (int m = 0; m < 4; ++m) af[m] = *(const bf16x8*)(ap[m] + k0);
#pragma unroll
            for (int bj = 0; bj < 2; ++bj)
#pragma unroll
                for (int n = 0; n < 2; ++n) bf[bj][n] = *(const bf16x8*)(bp[bj][n] + k0);
#pragma unroll
            for (int bj = 0; bj < 2; ++bj)
#pragma unroll
                for (int m = 0; m < 4; ++m)
#pragma unroll
                    for (int n = 0; n < 2; ++n) acc[bj][m][n] = __builtin_amdgcn_mfma_f32_16x16x32_bf16(bf[bj][n], af[m], acc[bj][m][n], 0, 0, 0);
            if (Hook::ON && ((k0 + 32) & 511) == 0) {
                const int g = (k0 + 32) / 512 - 1;
#pragma unroll
                for (int m = 0; m < 4; ++m) { const float r = H.ratio(u.pm * 256 + ai * 128 + wr * 64 + m * 16 + fr, g);
#pragma unroll
                    for (int bj = 0; bj < 2; ++bj)
#pragma unroll
                        for (int n = 0; n < 2; ++n) acc[bj][m][n] *= r; }
            }
        }
#pragma unroll
        for (int m = 0; m < 4; ++m) {
            const int row = u.pm * 256 + ai * 128 + wr * 64 + m * 16 + fr, colh = wc * 32 + 8 * fq;
            if constexpr (Epi::PAIR) E.pair(u, row, colh, acc[0][m][0], acc[0][m][1], acc[1][m][0], acc[1][m][1]);
            else { E(u, row, u.pn * 256 + colh, acc[0][m][0], acc[0][m][1]); E(u, row, u.pn * 256 + 128 + colh, acc[1][m][0], acc[1][m][1]); }
        }
    }
}

struct EpiInproj { static constexpr bool PAIR = false; bf16 *Z, *XBC, *U, *GT;
    __device__ __forceinline__ void operator()(const GUnit&, int row, int col, f32x4 lo, f32x4 hi) const {
        if (col < 2048) { for (int i = 0; i < 4; ++i) { lo[i] = siluf_(lo[i]); hi[i] = siluf_(hi[i]); } *(u32x4*)(Z + (size_t)row * 2048 + col) = pack8(lo, hi); }
        else if (col < 5120) *(u32x4*)(XBC + (size_t)row * 3072 + (col - 2048)) = pack8(lo, hi);
        else if (col < 6144) *(u32x4*)(U + (size_t)row * 1024 + (col - 5120)) = pack8(lo, hi);
        else { for (int i = 0; i < 4; ++i) { lo[i] = sigmoidf_(lo[i]); hi[i] = sigmoidf_(hi[i]); } *(u32x4*)(GT + (size_t)row * 2048 + (col - 6144)) = pack8(lo, hi); }
    } };
struct EpiPool { static constexpr bool PAIR = false; bf16* YPG; const bf16* GT;
    __device__ __forceinline__ void operator()(const GUnit& u, int row, int col, f32x4 lo, f32x4 hi) const {
        const int c = u.e * 256 + col; float g[8]; unpack8(*(const u32x4*)(GT + (size_t)row * 2048 + 1024 + c), g);
        for (int i = 0; i < 4; ++i) { lo[i] *= g[i]; hi[i] *= g[4 + i]; }
        *(u32x4*)(YPG + (size_t)row * 1024 + c) = pack8(lo, hi);
    } };
struct EpiOut { static constexpr bool PAIR = false; bf16* MIXED; const bf16 *GT, *YPG;
    __device__ __forceinline__ void operator()(const GUnit&, int row, int col, f32x4 lo, f32x4 hi) const {
        float g[8], y[8]; unpack8(*(const u32x4*)(GT + (size_t)row * 2048 + col), g); unpack8(*(const u32x4*)(YPG + (size_t)row * 1024 + col), y);
        for (int i = 0; i < 4; ++i) { lo[i] = lo[i] * g[i] + y[i]; hi[i] = hi[i] * g[4 + i] + y[4 + i]; }
        *(u32x4*)(MIXED + (size_t)row * 1024 + col) = pack8(lo, hi);
    } };
struct EpiMix { static constexpr bool PAIR = false; const float* x; float* X1;
    __device__ __forceinline__ void operator()(const GUnit&, int row, int col, f32x4 lo, f32x4 hi) const {
        const f32x4 a = *(const f32x4*)(x + (size_t)row * 1024 + col), b = *(const f32x4*)(x + (size_t)row * 1024 + col + 4);
        *(f32x4*)(X1 + (size_t)row * 1024 + col) = a + lo; *(f32x4*)(X1 + (size_t)row * 1024 + col + 4) = b + hi;
    } };
struct EpiGU { static constexpr bool PAIR = true; bf16* ACT; const float* b_gate_up;
    __device__ __forceinline__ void pair(const GUnit& u, int row, int colh, f32x4 g0, f32x4 g1, f32x4 u0, f32x4 u1) const {
        const int c = u.pn * 128 + colh; const float* bg = b_gate_up + (size_t)u.e * 2048 + c;
        const f32x4 bg0 = *(const f32x4*)bg, bg1 = *(const f32x4*)(bg + 4), bu0 = *(const f32x4*)(bg + 1024), bu1 = *(const f32x4*)(bg + 1028);
        f32x4 lo, hi;
        for (int i = 0; i < 4; ++i) {
            float ga = fminf(g0[i] + bg0[i], 7.f), up = fminf(fmaxf(u0[i] + bu0[i], -7.f), 7.f); lo[i] = (up + 1.f) * ga * sigmoidf_(1.702f * ga);
            ga = fminf(g1[i] + bg1[i], 7.f); up = fminf(fmaxf(u1[i] + bu1[i], -7.f), 7.f); hi[i] = (up + 1.f) * ga * sigmoidf_(1.702f * ga); }
        *(u32x4*)(ACT + (size_t)row * 1024 + c) = pack8(lo, hi);
    } };
struct EpiDN { static constexpr bool PAIR = false; bf16* YR; const float* b_down;
    __device__ __forceinline__ void operator()(const GUnit& u, int row, int col, f32x4 lo, f32x4 hi) const {
        const float* b = b_down + (size_t)u.e * 1024 + col; lo += *(const f32x4*)b; hi += *(const f32x4*)(b + 4);
        *(u32x4*)(YR + (size_t)row * 1024 + col) = pack8(lo, hi);
    } };
struct EpiF32 { static constexpr bool PAIR = false; float* C;
    __device__ __forceinline__ void operator()(const GUnit&, int row, int col, f32x4 lo, f32x4 hi) const { *(f32x4*)(C + (size_t)row * 1024 + col) = lo; *(f32x4*)(C + (size_t)row * 1024 + col + 4) = hi; } };
struct EpiPle { static constexpr bool PAIR = false; const float* TMP; float* X;
    __device__ __forceinline__ void operator()(const GUnit&, int row, int col, f32x4 lo, f32x4 hi) const {
        float* xp = X + (size_t)row * 1024 + col; const float* tp = TMP + (size_t)row * 1024 + col;
        const f32x4 t0 = *(const f32x4*)tp, t1 = *(const f32x4*)(tp + 4); f32x4 x0 = *(const f32x4*)xp, x1 = *(const f32x4*)(xp + 4);
        for (int i = 0; i < 4; ++i) { x0[i] += sigmoidf_(lo[i]) * t0[i]; x1[i] += sigmoidf_(hi[i]) * t1[i]; }
        *(f32x4*)xp = x0; *(f32x4*)(xp + 4) = x1;
    } };

__device__ __forceinline__ void tr_item(const float* W, int ldw, int n0src, int k0, bf16* WT, int K, int dstrow0, const float* kscale, const float* nscale, LAS float* scr, int lane) {
#pragma unroll 8
    for (int i = 0; i < 32; ++i) { const int kk = 2 * i + (lane >> 5); float v = W[(size_t)(k0 + kk) * ldw + n0src + (lane & 31)];
        if (kscale) v *= kscale[k0 + kk]; if (nscale) v *= nscale[n0src + (lane & 31)]; scr[kk * 33 + (lane & 31)] = v; }
    asm volatile("s_waitcnt lgkmcnt(0)" ::: "memory");
    const int c = lane & 7;
#pragma unroll
    for (int j = 0; j < 4; ++j) { const int n = (lane >> 3) + 8 * j; const LAS float* s = scr + (8 * c) * 33 + n;
        u32x4 o; o.x = pk2(s[0 * 33], s[1 * 33]); o.y = pk2(s[2 * 33], s[3 * 33]); o.z = pk2(s[4 * 33], s[5 * 33]); o.w = pk2(s[6 * 33], s[7 * 33]);
        *(u32x4*)(WT + (size_t)(dstrow0 + n) * K + k0 + 8 * c) = o; }
    asm volatile("s_waitcnt lgkmcnt(0)" ::: "memory");
}
__device__ __forceinline__ void p0_prologue(const Frame& F) {
    LAS float* scr = (LAS float*)(F.lds + F.wave * 16384);
    const int gw = F.wg * NWAVES + F.wave, NGW = F.G * NWAVES, lane = F.lane;
    constexpr int I_WIN = 16 * 257, I_WOUT = 32 * 32, I_WPOOL = 4 * 4 * 8, I_WMIX = 16 * 32, I_WPG = 16 * 32, I_WPP = 4 * 32, I_WGU = 32 * 16 * 64, I_WDN = 32 * 16 * 32;
    constexpr int NITEMS = I_WIN + I_WOUT + I_WPOOL + I_WMIX + I_WPG + I_WPP + I_WGU + I_WDN;
#pragma unroll 1
    for (int it = gw; it < NITEMS; it += NGW) {
        int r = it;
        if (r < I_WIN) { const int kb = r / 257, nb = r % 257; if (nb != 160) tr_item(F.w_in, NPROJ, 32 * nb, 64 * kb, F.WIN, 1024, 32 * nb - (nb > 160 ? 32 : 0), nullptr, nullptr, scr, lane); continue; } r -= I_WIN;
        if (r < I_WOUT) { const int kb = r / 32, nb = r % 32; tr_item(F.w_ssd_out, 1024, 32 * nb, 64 * kb, F.WOUT, 2048, 32 * nb, F.ssd_norm_g, nullptr, scr, lane); continue; } r -= I_WOUT;
        if (r < I_WPOOL) { const int g = r / 32, q = r % 32, kb = q / 8, nb = q % 8; tr_item(F.pool_w + (size_t)g * 65536, 256, 32 * nb, 64 * kb, F.WPOOL + (size_t)g * 65536, 256, 32 * nb, nullptr, F.pool_scale + g * 256, scr, lane); continue; } r -= I_WPOOL;
        if (r < I_WMIX) { const int kb = r / 32, nb = r % 32; tr_item(F.w_mix_out, 1024, 32 * nb, 64 * kb, F.WMIX, 1024, 32 * nb, nullptr, nullptr, scr, lane); continue; } r -= I_WMIX;
        if (r < I_WPG) { const int kb = r / 32, nb = r % 32; tr_item(F.w_ple_gate, 1024, 32 * nb, 64 * kb, F.WPG, 1024, 32 * nb, nullptr, nullptr, scr, lane); continue; } r -= I_WPG;
        if (r < I_WPP) { const int kb = r / 32, nb = r % 32; tr_item(F.w_ple_proj, 1024, 32 * nb, 64 * kb, F.WPP, 256, 32 * nb, nullptr, nullptr, scr, lane); continue; } r -= I_WPP;
        if (r < I_WGU) { const int e = r / 1024, q = r % 1024, kb = q / 64, nb = q % 64; const int c = 32 * nb, s = c >> 10, rr = c & 1023, dst = 256 * (rr >> 7) + 128 * s + (rr & 127);
            tr_item(F.w_gate_up + (size_t)e * 1024 * 2048, 2048, c, 64 * kb, F.WGU + (size_t)e * 2048 * 1024, 1024, dst, nullptr, nullptr, scr, lane); continue; } r -= I_WGU;
        { const int e = r / 512, q = r % 512, kb = q / 32, nb = q % 32; tr_item(F.w_down + (size_t)e * 1024 * 1024, 1024, 32 * nb, 64 * kb, F.WDN + (size_t)e * 1024 * 1024, 1024, 32 * nb, nullptr, nullptr, scr, lane); }
    }
#pragma unroll 1
    for (int row = gw; row < T; row += NGW) {
        const f32x4* xr = (const f32x4*)(F.x + (size_t)row * D) + lane;
        f32x4 v[4]; float s = 0.f;
#pragma unroll
        for (int j = 0; j < 4; ++j) { v[j] = xr[64 * j]; s += (v[j][0] * v[j][0] + v[j][1] * v[j][1]) + (v[j][2] * v[j][2] + v[j][3] * v[j][3]); }
        const float rs = rsqrtf(wave_sum(s) * (1.f / D) + EPS);
        u32x2* o8 = (u32x2*)(F.XN + (size_t)row * D) + lane;
#pragma unroll
        for (int j = 0; j < 4; ++j) { const f32x4 g = ((const f32x4*)F.mix_norm_g)[lane + 64 * j]; v[j] = v[j] * rs * g; u32x2 w; w.x = pk2(v[j][0], v[j][1]); w.y = pk2(v[j][2], v[j][3]); o8[64 * j] = w; }
        float mydt = 0.f;
#pragma unroll 1
        for (int e = 0; e < 32; ++e) { float pa = 0.f;
#pragma unroll
            for (int j = 0; j < 4; ++j)
#pragma unroll
                for (int i = 0; i < 4; ++i) pa = fmaf(v[j][i], F.w_in[(size_t)(4 * lane + 256 * j + i) * NPROJ + 5120 + e], pa);
            pa = wave_sum(pa); if (lane == e) mydt = pa; }
        if (lane < 32) { const float dtr = mydt + F.dt_bias[lane]; F.DT[(size_t)row * 32 + lane] = dtr > 20.f ? dtr : log1pf(__expf(dtr)); }
    }
    const size_t n8 = (size_t)T * DPLE / 8;
#pragma unroll 1
    for (size_t i = (size_t)F.wg * NTHREADS + F.tid; i < n8; i += (size_t)F.G * NTHREADS) { const f32x4 a = ((const f32x4*)F.p)[2 * i], b = ((const f32x4*)F.p)[2 * i + 1]; ((u32x4*)F.PB)[i] = pack8(a, b); }
}

template <class Epi, class Hook>
__device__ __forceinline__ void dense_gemm_phase(const Frame& F, const bf16* A, int lda, const bf16* Bt, int K, int nM, int nN, const Epi& E, const Hook& H) {
#pragma unroll 1
    for (int ui = F.wg; ui < nM * nN; ui += F.G) { GUnit u; u.pm = ui / nN; u.pn = ui % nN; u.e = 0; u.a = A; u.bt = Bt; sgemm_unit(u, lda, K, nullptr, E, H, F.wave, F.lane); }
}

__device__ __forceinline__ void p2_pool(const Frame& F) {
    const size_t n8 = (size_t)T * 1024 / 8;
#pragma unroll 1
    for (size_t i = (size_t)F.wg * NTHREADS + F.tid; i < n8; i += (size_t)F.G * NTHREADS) {
        const int t = (int)(i >> 7), c = (int)(i & 127) * 8, gi = c >> 8, w = 2 << gi, pos = t % SEQ, cnt = (pos + 1 < w) ? pos + 1 : w;
        float s[8] = {0, 0, 0, 0, 0, 0, 0, 0}, u0[8] = {0, 0, 0, 0, 0, 0, 0, 0};
#pragma unroll 1
        for (int j = 0; j < cnt; ++j) { float f[8]; unpack8(*(const u32x4*)(F.U + (size_t)(t - j) * 1024 + c), f);
#pragma unroll
            for (int q = 0; q < 8; ++q) { s[q] += f[q]; if (j == 0) u0[q] = f[q]; } }
        const float inv = 1.f / (float)cnt; f32x4 lo, hi;
#pragma unroll
        for (int q = 0; q < 4; ++q) { lo[q] = s[q] * inv - u0[q]; hi[q] = s[4 + q] * inv - u0[4 + q]; }
        *(u32x4*)(F.PO + (size_t)t * 1024 + c) = pack8(lo, hi);
    }
}
__device__ __forceinline__ void p2_ssd_naive(const Frame& F) {
    LAS float* sx = (LAS float*)F.lds; LAS float* sB = sx + 128; LAS float* sC = sB + 256; LAS float* sq = sC + 256;
    const int tid = F.tid;
#pragma unroll 1
    for (int unit = F.wg; unit < NB * NH; unit += F.G) {
        const int b = unit / NH, h = unit % NH, g = h / 8, p = tid >> 3, nb = tid & 7;
        int cch = -1;
        if (tid < 64) cch = h * 64 + tid; else if (tid < 192) cch = 2048 + g * 128 + (tid - 64); else if (tid < 320) cch = 2560 + g * 128 + (tid - 192);
        float w0 = 0, w1 = 0, w2 = 0, w3 = 0, cb = 0;
        if (cch >= 0) { w0 = F.conv_w[cch]; w1 = F.conv_w[DCONV + cch]; w2 = F.conv_w[2 * DCONV + cch]; w3 = F.conv_w[3 * DCONV + cch]; cb = F.conv_b[cch]; }
        const float a = -__expf(F.a_log[h]), dsk = F.d_skip[h];
        float st[16];
#pragma unroll
        for (int i = 0; i < 16; ++i) st[i] = 0.f;
        float x1 = 0.f, x2 = 0.f, x3 = 0.f;
        __syncthreads();
#pragma unroll 1
        for (int t = 0; t < SEQ; ++t) {
            const size_t row = (size_t)(b * SEQ + t); const int buf = t & 1;
            if (cch >= 0) {
                const float x0 = bf2f(F.XBC[row * DCONV + cch]);
                float v = cb + w3 * x0 + w2 * x1 + w1 * x2 + w0 * x3; x3 = x2; x2 = x1; x1 = x0; v = siluf_(v);
                if (tid < 64) sx[buf * 64 + tid] = v; else if (tid < 192) sB[buf * 128 + tid - 64] = v; else sC[buf * 128 + tid - 192] = v;
            }
            const float dt = F.DT[row * 32 + h], dA = __expf(dt * a);
            __syncthreads();
            const float xv = sx[buf * 64 + p], dx = dt * xv; float y = 0.f;
#pragma unroll
            for (int i = 0; i < 16; ++i) { st[i] = st[i] * dA + dx * sB[buf * 128 + nb * 16 + i]; y = fmaf(sC[buf * 128 + nb * 16 + i], st[i], y); }
            y += __shfl_xor(y, 1); y += __shfl_xor(y, 2); y += __shfl_xor(y, 4);
            if (nb == 0) { const float v = (y + dsk * xv) * bf2f(F.Z[row * DIN + h * 64 + p]); F.V[row * DIN + h * 64 + p] = (bf16)f2bf(v); sq[p] = v * v; }
            __syncthreads();
            if (tid < 64) { const float ssum = wave_sum(sq[tid]); if (tid == 0) F.SS[row * 32 + h] = ssum; }
        }
        __syncthreads();
    }
}
__device__ __forceinline__ void p3_rstd(const Frame& F) {
#pragma unroll 1
    for (int i = F.wg * NTHREADS + F.tid; i < T * 4; i += F.G * NTHREADS) { float s = 0.f;
#pragma unroll
        for (int q = 0; q < 8; ++q) s += F.SS[(size_t)i * 8 + q];
        F.RSTD[i] = rsqrtf(s * (1.f / 512.f) + EPS); }
}
__device__ __forceinline__ void p6_router(const Frame& F) {
    LAS int* cnt = (LAS int*)F.lds;
    if (F.tid < 32) cnt[F.tid] = 0;
    __syncthreads();
    const int lane = F.lane;
#pragma unroll 1
    for (int rr = 0; rr < 8; ++rr) {
        const int row = F.wg * 64 + F.wave * 8 + rr;
        const f32x4* xr = (const f32x4*)(F.out + (size_t)row * D) + lane;
        f32x4 v[4]; float s = 0.f;
#pragma unroll
        for (int j = 0; j < 4; ++j) { v[j] = xr[64 * j]; s += (v[j][0] * v[j][0] + v[j][1] * v[j][1]) + (v[j][2] * v[j][2] + v[j][3] * v[j][3]); }
        const float rs = rsqrtf(wave_sum(s) * (1.f / D) + EPS);
        u32x2* o8 = (u32x2*)(F.XN + (size_t)row * D) + lane;
#pragma unroll
        for (int j = 0; j < 4; ++j) { const f32x4 g = ((const f32x4*)F.ffn_norm_g)[lane + 64 * j]; v[j] = v[j] * rs * g; u32x2 w; w.x = pk2(v[j][0], v[j][1]); w.y = pk2(v[j][2], v[j][3]); o8[64 * j] = w; }
        float lg[32];
#pragma unroll
        for (int e = 0; e < 32; ++e) lg[e] = 0.f;
#pragma unroll
        for (int j = 0; j < 4; ++j)
#pragma unroll
            for (int i = 0; i < 4; ++i) { const f32x4* wr = (const f32x4*)(F.w_router + (size_t)(4 * lane + 256 * j + i) * 32); const float xv = v[j][i];
#pragma unroll
                for (int q = 0; q < 8; ++q) { const f32x4 w = wr[q]; lg[4 * q] = fmaf(xv, w[0], lg[4 * q]); lg[4 * q + 1] = fmaf(xv, w[1], lg[4 * q + 1]); lg[4 * q + 2] = fmaf(xv, w[2], lg[4 * q + 2]); lg[4 * q + 3] = fmaf(xv, w[3], lg[4 * q + 3]); } }
#pragma unroll
        for (int e = 0; e < 32; ++e) lg[e] = wave_sum(lg[e]) + F.b_router[e];
        float tv[4]; int ti[4];
#pragma unroll
        for (int k = 0; k < 4; ++k) { float best = -INFINITY; int bi = 0;
#pragma unroll
            for (int e = 0; e < 32; ++e) if (lg[e] > best) { best = lg[e]; bi = e; }
            tv[k] = best; ti[k] = bi;
#pragma unroll
            for (int e = 0; e < 32; ++e) if (e == bi) lg[e] = -INFINITY; }
        float ex[4], se = 0.f;
#pragma unroll
        for (int k = 0; k < 4; ++k) { ex[k] = __expf(tv[k] - tv[0]); se += ex[k]; }
        if (lane == 0) {
#pragma unroll
            for (int k = 0; k < 4; ++k) { F.TIDX[row * 4 + k] = ti[k]; F.TW[row * 4 + k] = ex[k] / se; __hip_atomic_fetch_add(cnt + ti[k], 1, __ATOMIC_RELAXED, __HIP_MEMORY_SCOPE_WORKGROUP); } }
    }
    __syncthreads();
    if (F.tid < 32) F.CNT[F.wg * 32 + F.tid] = cnt[F.tid];
}
__device__ __forceinline__ void p7_route(const Frame& F) {
    LAS int* base = (LAS int*)F.lds; LAS int* tot = base + 32; LAS int* pstart = tot + 32; LAS int* earr = pstart + 64;
    const int tid = F.tid;
    if (tid < 32) { int tt = 0, bb = 0;
#pragma unroll 1
        for (int w = 0; w < 256; ++w) { const int c = F.CNT[w * 32 + tid]; tt += c; if (w < F.wg) bb += c; }
        tot[tid] = tt; base[tid] = bb; }
    if (tid < 256) earr[tid] = F.TIDX[F.wg * 256 + tid];
    __syncthreads();
    if (tid == 0) { int s = 0;
#pragma unroll 1
        for (int e = 0; e < 32; ++e) { pstart[e] = s; s += (tot[e] + 255) / 256 * 256; } pstart[32] = s; }
    __syncthreads();
    if (tid < 256) { const int e = earr[tid]; int lr = 0;
#pragma unroll 1
        for (int j = 0; j < tid; ++j) lr += (earr[j] == e) ? 1 : 0;
        const int d = pstart[e] + base[e] + lr; F.DEST[F.wg * 256 + tid] = d; F.ROWTOK[d] = F.wg * 64 + (tid >> 2); }
    if (F.wg < 32) { const int e = F.wg;
#pragma unroll 1
        for (int r = pstart[e] + tot[e] + tid; r < pstart[e + 1]; r += NTHREADS) F.ROWTOK[r] = 0; }
    if (F.wg == 0 && tid < 33) F.PSTART[tid] = pstart[tid];
}
__device__ __forceinline__ int expert_of_row(const int* ps, int row) { int e = 0;
#pragma unroll 1
    for (int q = 1; q < 32; ++q) if (row >= ps[q]) e = q;
    return e; }
__device__ __forceinline__ void p8_moe_gu(const Frame& F) {
    const int nrt = F.PSTART[32] / 256; const EpiGU E{F.ACT, F.b_gate_up}; const NoHook H;
#pragma unroll 1
    for (int ui = F.wg; ui < nrt * 8; ui += F.G) { GUnit u; u.pm = ui >> 3; u.pn = ui & 7; u.e = expert_of_row(F.PSTART, u.pm * 256); u.a = F.XN; u.bt = F.WGU + (size_t)u.e * 2048 * 1024;
        sgemm_unit(u, 1024, 1024, F.ROWTOK, E, H, F.wave, F.lane); }
}
__device__ __forceinline__ void p9_moe_dn(const Frame& F) {
    const int nrt = F.PSTART[32] / 256; const EpiDN E{F.YR, F.b_down}; const NoHook H;
#pragma unroll 1
    for (int ui = F.wg; ui < nrt * 4; ui += F.G) { GUnit u; u.pm = ui >> 2; u.pn = ui & 3; u.e = expert_of_row(F.PSTART, u.pm * 256); u.a = F.ACT; u.bt = F.WDN + (size_t)u.e * 1024 * 1024;
        sgemm_unit(u, 1024, 1024, nullptr, E, H, F.wave, F.lane); }
}
__device__ __forceinline__ void p10_combine(const Frame& F) {
    const int gw = F.wg * NWAVES + F.wave, NGW = F.G * NWAVES, lane = F.lane;
#pragma unroll 1
    for (int row = gw; row < T; row += NGW) {
        f32x4* xr = (f32x4*)(F.out + (size_t)row * D) + lane;
        f32x4 v[4];
#pragma unroll
        for (int j = 0; j < 4; ++j) v[j] = xr[64 * j];
#pragma unroll
        for (int k = 0; k < 4; ++k) { const int d = F.DEST[row * 4 + k]; const float w = F.TW[row * 4 + k]; const u32x2* yr = (const u32x2*)(F.YR + (size_t)d * 1024) + lane;
#pragma unroll
            for (int j = 0; j < 4; ++j) { const u32x2 q = yr[64 * j]; v[j][0] += w * bf2f(q.x & 0xffffu); v[j][1] += w * bf2f(q.x >> 16); v[j][2] += w * bf2f(q.y & 0xffffu); v[j][3] += w * bf2f(q.y >> 16); } }
        float s = 0.f;
#pragma unroll
        for (int j = 0; j < 4; ++j) { xr[64 * j] = v[j]; s += (v[j][0] * v[j][0] + v[j][1] * v[j][1]) + (v[j][2] * v[j][2] + v[j][3] * v[j][3]); }
        const float rs = rsqrtf(wave_sum(s) * (1.f / D) + EPS);
        u32x2* o8 = (u32x2*)(F.XN + (size_t)row * D) + lane;
#pragma unroll
        for (int j = 0; j < 4; ++j) { const f32x4 g = ((const f32x4*)F.ple_norm_g)[lane + 64 * j]; const f32x4 q = v[j] * rs * g; u32x2 w; w.x = pk2(q[0], q[1]); w.y = pk2(q[2], q[3]); o8[64 * j] = w; }
    }
}
__device__ __forceinline__ void p12_final(const Frame& F) {
    const int gw = F.wg * NWAVES + F.wave, NGW = F.G * NWAVES, lane = F.lane;
#pragma unroll 1
    for (int row = gw; row < T; row += NGW) {
        f32x4* xr = (f32x4*)(F.out + (size_t)row * D) + lane; f32x4 v[4]; float s = 0.f;
#pragma unroll
        for (int j = 0; j < 4; ++j) { v[j] = xr[64 * j]; s += (v[j][0] * v[j][0] + v[j][1] * v[j][1]) + (v[j][2] * v[j][2] + v[j][3] * v[j][3]); }
        const float rs = rsqrtf(wave_sum(s) * (1.f / D) + EPS);
#pragma unroll
        for (int j = 0; j < 4; ++j) { const f32x4 g = ((const f32x4*)F.final_norm_g)[lane + 64 * j]; xr[64 * j] = v[j] * rs * g; }
    }
}

constexpr int LDS_BYTES = 147456;

__global__ void __launch_bounds__(NTHREADS, 2) mk_fwd(Args args) {
    extern __shared__ __attribute__((aligned(16))) unsigned char lds_raw[];
    Frame F;
    F.lds = (LAS unsigned char*)lds_raw; F.tid = threadIdx.x; F.lane = F.tid & 63; F.wave = __builtin_amdgcn_readfirstlane(F.tid >> 6); F.G = gridDim.x; F.wg = blockIdx.x;
    unsigned char* ws = args.ws;
    F.x = args.in[0]; F.p = args.in[1]; F.mix_norm_g = args.in[2]; F.w_in = args.in[3]; F.conv_w = args.in[4]; F.conv_b = args.in[5]; F.dt_bias = args.in[6]; F.a_log = args.in[7]; F.d_skip = args.in[8];
    F.ssd_norm_g = args.in[9]; F.w_ssd_out = args.in[10]; F.pool_w = args.in[11]; F.pool_scale = args.in[12]; F.w_mix_out = args.in[13]; F.ffn_norm_g = args.in[14]; F.w_router = args.in[15];
    F.b_router = args.in[16]; F.w_gate_up = args.in[17]; F.b_gate_up = args.in[18]; F.w_down = args.in[19]; F.b_down = args.in[20]; F.ple_norm_g = args.in[21]; F.w_ple_gate = args.in[22];
    F.w_ple_proj = args.in[23]; F.final_norm_g = args.in[24]; F.out = args.out;
    F.WIN = (bf16*)(ws + WS_WIN); F.WOUT = (bf16*)(ws + WS_WOUT); F.WPOOL = (bf16*)(ws + WS_WPOOL); F.WMIX = (bf16*)(ws + WS_WMIX); F.WPG = (bf16*)(ws + WS_WPG); F.WPP = (bf16*)(ws + WS_WPP);
    F.WGU = (bf16*)(ws + WS_WGU); F.WDN = (bf16*)(ws + WS_WDN); F.XN = (bf16*)(ws + WS_XN); F.PO = (bf16*)(ws + WS_PO); F.YPG = (bf16*)(ws + WS_YPG); F.MIXED = (bf16*)(ws + WS_MIXED);
    F.PB = (bf16*)(ws + WS_PB); F.Z = (bf16*)(ws + WS_Z); F.XBC = (bf16*)(ws + WS_XBC); F.U = (bf16*)(ws + WS_U); F.GT = (bf16*)(ws + WS_GT); F.V = (bf16*)(ws + WS_V);
    F.ACT = (bf16*)(ws + WS_ACT); F.YR = (bf16*)(ws + WS_YR); F.DT = (float*)(ws + WS_DT); F.SS = (float*)(ws + WS_SS); F.RSTD = (float*)(ws + WS_RSTD); F.TMP = (float*)(ws + WS_TMP);
    { unsigned char* r = ws + WS_ROUTE; F.TIDX = (int*)r; r += NA * 4; F.TW = (float*)r; r += NA * 4; F.DEST = (int*)r; r += NA * 4; F.ROWTOK = (int*)r; r += MAXROWS * 4; F.CNT = (int*)r; r += 256 * 32 * 4; F.PSTART = (int*)r; }

    volatile LAS unsigned* MISC = (volatile LAS unsigned*)(F.lds + 131072);
    if (F.tid < 64) MISC[F.tid] = 0u;
    __syncthreads();
    const int lo = args.ph_lo, hi = args.ph_hi;
    XcdBarrier bar; bar.bar = (unsigned*)(ws + WS_CTL) + CW_BAR; bar.x = 0; bar.st = nullptr;
    if (hi - lo > 1) bar = xcd_barrier_post((unsigned*)(ws + WS_CTL) + CW_BAR, MISC + 8);
#define IN(k) (lo <= (k) && (k) < hi)
#define SEAM(k) do { if (IN(k) && IN((k) + 1)) xcd_barrier(bar); } while (0)
    const NoHook NH_;
    if (IN(0)) { p0_prologue(F); } SEAM(0);
    if (IN(1)) { const EpiInproj E{F.Z, F.XBC, F.U, F.GT}; dense_gemm_phase(F, F.XN, 1024, F.WIN, 1024, 64, 32, E, NH_); } SEAM(1);
    if (IN(2)) { p2_pool(F); p2_ssd_naive(F); } SEAM(2);
    if (IN(3)) { p3_rstd(F); const EpiPool E{F.YPG, F.GT};
#pragma unroll 1
        for (int ui = F.wg; ui < 64 * 4; ui += F.G) { GUnit u; u.pm = ui >> 2; u.pn = 0; u.e = ui & 3; u.a = F.PO + 256 * u.e; u.bt = F.WPOOL + (size_t)u.e * 65536; sgemm_unit(u, 1024, 256, nullptr, E, NH_, F.wave, F.lane); } } SEAM(3);
    if (IN(4)) { const EpiOut E{F.MIXED, F.GT, F.YPG}; const RstdHook H{F.RSTD}; dense_gemm_phase(F, F.V, 2048, F.WOUT, 2048, 64, 4, E, H); } SEAM(4);
    if (IN(5)) { const EpiMix E{F.x, F.out}; dense_gemm_phase(F, F.MIXED, 1024, F.WMIX, 1024, 64, 4, E, NH_); } SEAM(5);
    if (IN(6)) { p6_router(F); } SEAM(6);
    if (IN(7)) { p7_route(F); } SEAM(7);
    if (IN(8)) { p8_moe_gu(F); } SEAM(8);
    if (IN(9)) { p9_moe_dn(F); } SEAM(9);
    if (IN(10)) { p10_combine(F); } SEAM(10);
    if (IN(11)) { const EpiF32 E1{F.TMP}; const EpiPle E2{F.TMP, F.out};
#pragma unroll 1
        for (int ui = F.wg; ui < 64 * 4; ui += F.G) { GUnit u; u.pm = ui >> 2; u.pn = ui & 3; u.e = 0; u.a = F.PB; u.bt = F.WPP; sgemm_unit(u, 256, 256, nullptr, E1, NH_, F.wave, F.lane);
            asm volatile("s_waitcnt vmcnt(0)" ::: "memory"); __syncthreads();
            u.a = F.XN; u.bt = F.WPG; sgemm_unit(u, 1024, 1024, nullptr, E2, NH_, F.wave, F.lane); } } SEAM(11);
    if (IN(12)) { p12_final(F); }
#undef IN
#undef SEAM
}
}

extern "C" void kernel_launch(void* const* d_in, const int* in_sizes, int n_in, void* d_out, int out_size, void* d_ws, size_t ws_size, hipStream_t stream) {
    static int grid = 0;
    if (grid == 0) {
        if (n_in != 25 || in_sizes[0] != T * D || out_size != T * D || ws_size < WS_END) { fprintf(stderr, "kernel_launch: unexpected shapes (n_in %d, out %d, ws %zu)\n", n_in, out_size, ws_size); grid = -1; return; }
        int dev = 0, cus = 0, per_cu = 0;
        if (hipGetDevice(&dev) != hipSuccess || hipDeviceGetAttribute(&cus, hipDeviceAttributeMultiprocessorCount, dev) != hipSuccess) { grid = -1; return; }
        if (hipFuncSetAttribute((const void*)mk_fwd, hipFuncAttributeMaxDynamicSharedMemorySize, LDS_BYTES) != hipSuccess) { fprintf(stderr, "kernel_launch: hipFuncSetAttribute failed\n"); grid = -1; return; }
        if (hipOccupancyMaxActiveBlocksPerMultiprocessor(&per_cu, (const void*)mk_fwd, NTHREADS, LDS_BYTES) != hipSuccess || per_cu < 1) { fprintf(stderr, "kernel_launch: occupancy query says %d blocks/CU\n", per_cu); (void)hipGetLastError(); grid = -1; return; }
        grid = cus;
        if (grid != 256) { fprintf(stderr, "kernel_launch: built for a 256-CU device, found %d CUs\n", cus); grid = -1; return; }
    }
    if (grid < 0) return;
    (void)hipMemsetAsync((char*)d_ws + WS_CTL, 0, CTL_ZERO_BYTES, stream);
    Args a; memset(&a, 0, sizeof(a));
    for (int i = 0; i < 25; ++i) a.in[i] = (const float*)d_in[i];
    a.out = (float*)d_out; a.ws = (unsigned char*)d_ws;
#if MK_MULTI
    for (int ph = 0; ph < NPH; ++ph) { a.ph_lo = ph; a.ph_hi = ph + 1; hipLaunchKernelGGL(mk_fwd, dim3(grid), dim3(NTHREADS), LDS_BYTES, stream, a); }
#else
    a.ph_lo = 0; a.ph_hi = NPH;
    void* kargs[] = {&a};
    hipError_t e = hipLaunchCooperativeKernel((const void*)mk_fwd, dim3(grid), dim3(NTHREADS), kargs, LDS_BYTES, stream);
    if (e != hipSuccess) fprintf(stderr, "kernel_launch: cooperative launch failed: %s\n", hipGetErrorString(e));
#endif
}
```

```cpp
#include <hip/hip_runtime.h>
#include <cstdio>
#include <cstdint>
#include <cstring>

#ifndef PGMASK
#define PGMASK 0xB3A
#endif
#ifndef MK_MULTI
#define MK_MULTI 0
#endif

#define LAS __attribute__((address_space(3)))
#define GAS __attribute__((address_space(1)))
typedef unsigned short bf16;
typedef short bf16x8 __attribute__((ext_vector_type(8)));
typedef float f32x4 __attribute__((ext_vector_type(4)));
typedef unsigned u32x4 __attribute__((ext_vector_type(4)));
typedef unsigned u32x2 __attribute__((ext_vector_type(2)));

namespace {
constexpr int T = 16384, SEQ = 2048, NB = 8, D = 1024;
constexpr int DIN = 2048, NH = 32, DCONV = 3072, NPROJ = 8224;
constexpr int NE = 32, DE = 1024, DPLE = 256;
constexpr int NA = T * 4;
constexpr int MAXROWS = NA + NE * 256;
constexpr float EPS = 1e-6f;
constexpr int NWAVES = 8, NTHREADS = 512;
constexpr int NPH = 13;
constexpr size_t MiB = 1u << 20;
constexpr size_t WS_CTL = 0, CTL_ZERO_BYTES = 1 * MiB;
constexpr size_t WS_WIN = 2 * MiB, WS_WOUT = 18 * MiB, WS_WPOOL = 22 * MiB, WS_WMIX = 23 * MiB, WS_WPG = 25 * MiB, WS_WPP = 27 * MiB;
constexpr size_t WS_WGU = 28 * MiB, WS_WDN = 156 * MiB;
constexpr size_t WS_XN = 220 * MiB, WS_DT = 252 * MiB, WS_SS = 254 * MiB, WS_RSTD = 256 * MiB, WS_PO = 257 * MiB, WS_YPG = 289 * MiB, WS_MIXED = 321 * MiB, WS_PB = 353 * MiB;
constexpr size_t WS_ROUTE = 361 * MiB;
constexpr size_t WS_Z = 364 * MiB, WS_XBC = 428 * MiB, WS_U = 524 * MiB, WS_GT = 556 * MiB, WS_V = 620 * MiB;
constexpr size_t WS_ACT = 364 * MiB, WS_YR = 508 * MiB;
constexpr size_t WS_TMP = 684 * MiB, WS_END = 748 * MiB;
constexpr int CW_BAR = 4096;

__device__ __forceinline__ float bf2f(unsigned v) { return __uint_as_float(v << 16); }
__device__ __forceinline__ unsigned f2bf(float f) { unsigned u = __float_as_uint(f); return (u + 0x7fffu + ((u >> 16) & 1u)) >> 16; }
__device__ __forceinline__ unsigned pk2(float lo, float hi) { unsigned r; asm volatile("v_cvt_pk_bf16_f32 %0, %1, %2" : "=v"(r) : "v"(lo), "v"(hi)); return r; }
__device__ __forceinline__ float wave_sum(float v) {
#pragma unroll
    for (int o = 1; o < 64; o <<= 1) v += __shfl_xor(v, o);
    return v;
}
__device__ __forceinline__ float sigmoidf_(float x) { return 1.f / (1.f + __expf(-x)); }
__device__ __forceinline__ float siluf_(float x) { return x / (1.f + __expf(-x)); }
__device__ __forceinline__ void unpack8(const u32x4 w, float (&f)[8]) {
    f[0] = bf2f(w.x & 0xffffu); f[1] = bf2f(w.x >> 16); f[2] = bf2f(w.y & 0xffffu); f[3] = bf2f(w.y >> 16);
    f[4] = bf2f(w.z & 0xffffu); f[5] = bf2f(w.z >> 16); f[6] = bf2f(w.w & 0xffffu); f[7] = bf2f(w.w >> 16);
}
__device__ __forceinline__ u32x4 pack8(const f32x4 lo, const f32x4 hi) { u32x4 w; w.x = pk2(lo[0], lo[1]); w.y = pk2(lo[2], lo[3]); w.z = pk2(hi[0], hi[1]); w.w = pk2(hi[2], hi[3]); return w; }
__host__ __device__ __forceinline__ int perm32(int rho) { const int n = rho >> 4, i = rho & 15; return 8 * (i >> 2) + 4 * n + (i & 3); }

#define XB_TMO      128
#define XB_XCNT(j)  (256  + 64 * (j))
#define XB_XSUB(j)  (1280 + 64 * (j))
#define XB_XGEN(j)  (2304 + 64 * (j))
#define XB_TOP      3328
#define XB_TOPGEN   3392
#define XCD_BAR_WORDS 3456
#define XB_SPIN_CAP (1u << 18)
__device__ __forceinline__ unsigned xb_ld(unsigned* p)              { return __hip_atomic_load(p, __ATOMIC_RELAXED, __HIP_MEMORY_SCOPE_AGENT); }
__device__ __forceinline__ unsigned xb_add(unsigned* p, unsigned v) { return __hip_atomic_fetch_add(p, v, __ATOMIC_RELAXED, __HIP_MEMORY_SCOPE_AGENT); }
__device__ __forceinline__ unsigned xb_xcc_id() { return (unsigned)__builtin_amdgcn_s_getreg((3 << 11) | 20) & 0xFu; }
#define XB_SPIN(cond, bar) do { unsigned _sp = 0; while (cond) { __builtin_amdgcn_s_sleep(1); \
    if ((++_sp & 255u) == 0u) { if (xb_ld(&(bar)[XB_TMO])) break; if (_sp > XB_SPIN_CAP) { atomicAdd(&(bar)[XB_TMO], 1u); break; } } } } while (0)
struct XcdBarrier { unsigned* bar; unsigned x; volatile LAS unsigned* st; };
__device__ __forceinline__ XcdBarrier xcd_barrier_post(unsigned* bar, volatile LAS unsigned* st) {
    XcdBarrier b; b.bar = bar; b.x = xb_xcc_id(); b.st = st;
    if (threadIdx.x == 0) (void)xb_add(&bar[XB_XCNT(b.x)], 1u);
    return b;
}
__device__ __forceinline__ void xcd_barrier_complete(unsigned* bar, unsigned x, unsigned& nloc, unsigned& nx) {
    const unsigned G = gridDim.x * gridDim.y * gridDim.z;
    unsigned sum, cnt, mine, sp = 0u;
    for (;;) {
        sum = 0u; cnt = 0u; mine = 0u;
#pragma unroll
        for (unsigned j = 0; j < 16; ++j) { const unsigned c = xb_ld(&bar[XB_XCNT(j)]); sum += c; cnt += (c > 0u) ? 1u : 0u; mine = (j == x) ? c : mine; }
        if (sum == G) break;
        __builtin_amdgcn_s_sleep(1);
        if ((++sp & 255u) == 0u) { if (xb_ld(&bar[XB_TMO])) break; if (sp > XB_SPIN_CAP) { atomicAdd(&bar[XB_TMO], 1u); break; } }
    }
    nloc = mine > 0u ? mine : 1u; nx = cnt > 0u ? cnt : 1u;
}
__device__ __forceinline__ void xcd_barrier(const XcdBarrier& b) {
    asm volatile("s_waitcnt vmcnt(0)" ::: "memory");
    __syncthreads();
    if (threadIdx.x == 0) {
        unsigned* bar = b.bar;
        __builtin_amdgcn_s_waitcnt(0);
        unsigned nloc = b.st[0], nx = b.st[1];
        if (nloc == 0u) { xcd_barrier_complete(bar, b.x, nloc, nx); b.st[0] = nloc; b.st[1] = nx; }
        const unsigned old = xb_add(&bar[XB_XSUB(b.x)], 1u);
        const unsigned gen = old / nloc;
        if (old + 1u == (gen + 1u) * nloc) {
            __builtin_amdgcn_fence(__ATOMIC_RELEASE, "agent");
            asm volatile("s_waitcnt vmcnt(0)" ::: "memory");
            const unsigned og = xb_add(&bar[XB_TOP], 1u);
            const unsigned tg = og / nx;
            if (og + 1u == (tg + 1u) * nx) xb_add(&bar[XB_TOPGEN], 1u);
            else XB_SPIN(xb_ld(&bar[XB_TOPGEN]) == tg, bar);
            __builtin_amdgcn_fence(__ATOMIC_ACQUIRE, "agent");
            xb_add(&bar[XB_XGEN(b.x)], 1u);
            asm volatile("s_waitcnt vmcnt(0)" ::: "memory");
        } else {
            XB_SPIN(xb_ld(&bar[XB_XGEN(b.x)]) == gen, bar);
            __builtin_amdgcn_fence(__ATOMIC_ACQUIRE, "agent");
            asm volatile("s_waitcnt vmcnt(0)" ::: "memory");
        }
    }
    __syncthreads();
}

struct Args { const float* in[25]; float* out; unsigned char* ws; int ph_lo, ph_hi; };
struct Frame {
    LAS unsigned char* lds; int tid, lane, wave, G, wg;
    const float *x, *p, *mix_norm_g, *w_in, *conv_w, *conv_b, *dt_bias, *a_log, *d_skip, *ssd_norm_g, *w_ssd_out, *pool_w, *pool_scale, *w_mix_out, *ffn_norm_g, *w_router, *b_router,
        *w_gate_up, *b_gate_up, *w_down, *b_down, *ple_norm_g, *w_ple_gate, *w_ple_proj, *final_norm_g;
    float* out;
    bf16 *WIN, *WOUT, *WPOOL, *WMIX, *WPG, *WPP, *WGU, *WDN;
    bf16 *XN, *PO, *YPG, *MIXED, *PB, *Z, *XBC, *U, *GT, *V, *ACT, *YR;
    float *DT, *SS, *RSTD, *TMP;
    int *TIDX, *DEST, *ROWTOK, *CNT, *PSTART, *TILE_E; float* TW;
};

struct GUnit { int pm, pn, e; const bf16* a; const bf16* bt; };
struct NoHook { static constexpr bool ON = false; __device__ __forceinline__ float ratio(int, int) const { return 1.f; } };
struct RstdHook { static constexpr bool ON = true; const float* rstd;
    __device__ __forceinline__ float ratio(int row, int g) const { return rstd[row * 4 + g]; } };

template <class Epi, class Hook>
__device__ __forceinline__ void sgemm_unit(const GUnit& u, int lda, int K, const int* gather, const Epi& E, const Hook& H, int wave, int lane) {
    const int wr = wave >> 2, wc = wave & 3, fr = lane & 15, fq = lane >> 4;
#pragma unroll 1
    for (int ai = 0; ai < 2; ++ai) {
        f32x4 acc[2][4][2];
#pragma unroll
        for (int bj = 0; bj < 2; ++bj)
#pragma unroll
            for (int m = 0; m < 4; ++m)
#pragma unroll
                for (int n = 0; n < 2; ++n) acc[bj][m][n] = (f32x4){0.f, 0.f, 0.f, 0.f};
        const bf16* ap[4]; const bf16* bp[2][2];
#pragma unroll
        for (int m = 0; m < 4; ++m) { const int row = u.pm * 256 + ai * 128 + wr * 64 + m * 16 + fr; const int src = gather ? gather[row] : row; ap[m] = u.a + (size_t)src * lda + 8 * fq; }
#pragma unroll
        for (int bj = 0; bj < 2; ++bj)
#pragma unroll
            for (int n = 0; n < 2; ++n) bp[bj][n] = u.bt + (size_t)(u.pn * 256 + bj * 128 + wc * 32 + perm32(n * 16 + fr)) * K + 8 * fq;
#pragma unroll 1
        for (int k0 = 0; k0 < K; k0 += 32) {
            bf16x8 af[4], bf[2][2];
#pragma unroll
            for (int m = 0; m < 4; ++m) af[m] = *(const bf16x8*)(ap[m] + k0);
#pragma unroll
            for (int bj = 0; bj < 2; ++bj)
#pragma unroll
                for (int n = 0; n < 2; ++n) bf[bj][n] = *(const bf16x8*)(bp[bj][n] + k0);
#pragma unroll
            for (int bj = 0; bj < 2; ++bj)
#pragma unroll
                for (int m = 0; m < 4; ++m)
#pragma unroll
                    for (int n = 0; n < 2; ++n) acc[bj][m][n] = __builtin_amdgcn_mfma_f32_16x16x32_bf16(bf[bj][n], af[m], acc[bj][m][n], 0, 0, 0);
            if (Hook::ON && ((k0 + 32) & 511) == 0) {
                const int g = (k0 + 32) / 512 - 1;
#pragma unroll
                for (int m = 0; m < 4; ++m) { const float r = H.ratio(u.pm * 256 + ai * 128 + wr * 64 + m * 16 + fr, g);
#pragma unroll
                    for (int bj = 0; bj < 2; ++bj)
#pragma unroll
                        for (int n = 0; n < 2; ++n) acc[bj][m][n] *= r; }
            }
        }
#pragma unroll
        for (int m = 0; m < 4; ++m) {
            const int row = u.pm * 256 + ai * 128 + wr * 64 + m * 16 + fr, colh = wc * 32 + 8 * fq;
            if constexpr (Epi::PAIR) E.pair(u, row, colh, acc[0][m][0], acc[0][m][1], acc[1][m][0], acc[1][m][1]);
            else { E(u, row, u.pn * 256 + colh, acc[0][m][0], acc[0][m][1]); E(u, row, u.pn * 256 + 128 + colh, acc[1][m][0], acc[1][m][1]); }
        }
    }
}


namespace pg {
constexpr int BK = 64, HALF = 128, HTB = HALF * BK * 2;
__host__ __device__ __forceinline__ int lds_byte(int r, int c) { const int st = (r >> 4) * 2 + (c >> 5), rr = r & 15, cc = c & 31, ob = rr * 64 + cc * 2; return st * 1024 + (ob ^ (((ob >> 9) & 1) << 5)); }
__host__ __device__ __forceinline__ void stage_rc(int b, int& R, int& C) { const int st = b / 1024, sb = b % 1024, swz = sb ^ (((sb >> 9) & 1) << 5); R = (st >> 1) * 16 + swz / 64; C = (st & 1) * 32 + (swz % 64) / 2; }

template <class Epi>
__device__ __forceinline__ void run_epi(const Epi& E, const f32x4 (&acc)[2][2][4][2], const GUnit& u, int wr, int wc, int fr, int fq) {
#pragma unroll
    for (int ai = 0; ai < 2; ++ai)
#pragma unroll
        for (int m = 0; m < 4; ++m) {
            const int row = u.pm * 256 + ai * 128 + wr * 64 + m * 16 + fr, colh = wc * 32 + 8 * fq;
            if constexpr (Epi::PAIR) E.pair(u, row, colh, acc[ai][0][m][0], acc[ai][0][m][1], acc[ai][1][m][0], acc[ai][1][m][1]);
            else { E(u, row, u.pn * 256 + colh, acc[ai][0][m][0], acc[ai][0][m][1]); E(u, row, u.pn * 256 + 128 + colh, acc[ai][1][m][0], acc[ai][1][m][1]); }
        }
}

template <class Epi, class Sched, class Hook, bool ALIGN_EPI, bool GATHER>
__device__ __forceinline__ void gemm_phase(LAS unsigned char* lds, const int lda, const int K, const int* gather, const Sched& S, const Epi& E, const Hook& H) {
    const int tid = threadIdx.x, wid = __builtin_amdgcn_readfirstlane(tid >> 6), lane = tid & 63, wr = wid >> 2, wc = wid & 3, fr = lane & 15, fq = lane >> 4;
    const int nt = K / BK;
    unsigned voffA[2], voffB[2]; int R0, C0;
    { int R, C; stage_rc(tid * 16, R, C); R0 = R; C0 = C; }
#pragma unroll
    for (int i = 0; i < 2; ++i) { const int R = R0 + 64 * i; const int Rb = (R & ~31) + perm32(R & 31); voffA[i] = (unsigned)(R * lda + C0) * 2u; voffB[i] = (unsigned)(Rb * K + C0) * 2u; }
    const size_t kstep = (size_t)(BK * 2);
    const size_t hstepA = (size_t)HALF * lda * 2, hstepB = (size_t)HALF * K * 2;
    const unsigned ldsw = (unsigned)wid * 1024u;
    const int aoff = lds_byte(wr * 64 + fr, fq * 8), boff = lds_byte(wc * 32 + fr, fq * 8);
#define PG_SA(b, h) (((b) * 2 + (h)) * HTB)
#define PG_SB(b, h) ((4 + (b) * 2 + (h)) * HTB)
#define PG_GLDS(gp, bufoff, i) __builtin_amdgcn_global_load_lds((const unsigned*)(gp), (LAS unsigned*)(lds + (bufoff) + ldsw + (i) * 8192), 16, 0, 0)
#define PG_STAGE_B(bufoff, gbase) do { _Pragma("unroll") for (int _i = 0; _i < 2; ++_i) PG_GLDS((const char*)(gbase) + voffB[_i], bufoff, _i); } while (0)
#define PG_STAGE_A(bufoff, kp, h, NX) do { _Pragma("unroll") for (int _i = 0; _i < 2; ++_i) { \
        const char* _g = GATHER ? (const char*)(kp) + ((NX) ? nOff[h][_i] : cOff[h][_i]) : (const char*)(kp) + (size_t)(h) * hstepA + voffA[_i]; PG_GLDS(_g, bufoff, _i); } } while (0)
#define PG_LDA(dst, b, h) do { _Pragma("unroll") for (int m = 0; m < 4; ++m) _Pragma("unroll") for (int k = 0; k < 2; ++k) dst[m][k] = *(const LAS bf16x8*)(lds + PG_SA(b, h) + aoff + m * 2048 + k * 1024); } while (0)
#define PG_LDB(dst, b, h) do { _Pragma("unroll") for (int n = 0; n < 2; ++n) _Pragma("unroll") for (int k = 0; k < 2; ++k) dst[n][k] = *(const LAS bf16x8*)(lds + PG_SB(b, h) + boff + n * 2048 + k * 1024); } while (0)
#define PG_MMA(ai, bj, At, Bt) do { __builtin_amdgcn_s_setprio(1); _Pragma("unroll") for (int m = 0; m < 4; ++m) _Pragma("unroll") for (int n = 0; n < 2; ++n) _Pragma("unroll") for (int k = 0; k < 2; ++k) \
        acc[ai][bj][m][n] = __builtin_amdgcn_mfma_f32_16x16x32_bf16(Bt[n][k], At[m][k], acc[ai][bj][m][n], 0, 0, 0); __builtin_amdgcn_s_setprio(0); } while (0)
#define PG_WAIT_V(n) asm volatile("s_waitcnt vmcnt(" #n ")" ::: "memory")
#define PG_WAIT_L(n) asm volatile("s_waitcnt lgkmcnt(" #n ")" ::: "memory")
#define PG_BAR __builtin_amdgcn_s_barrier()
#define PG_SCHED __builtin_amdgcn_sched_barrier(0)
    GUnit cur, nxt; int ui = 0;
    if (!S.next(0, cur)) return;
    unsigned cOff[2][2] = {{0u, 0u}, {0u, 0u}}, nOff[2][2] = {{0u, 0u}, {0u, 0u}};
    if constexpr (GATHER) {
#pragma unroll
        for (int h = 0; h < 2; ++h)
#pragma unroll
            for (int i = 0; i < 2; ++i) cOff[h][i] = (unsigned)(gather[cur.pm * 256 + h * 128 + R0 + 64 * i] * lda + C0) * 2u;
    }
    f32x4 acc[2][2][4][2];
#pragma unroll
    for (int a = 0; a < 2; ++a)
#pragma unroll
        for (int b = 0; b < 2; ++b)
#pragma unroll
            for (int m = 0; m < 4; ++m)
#pragma unroll
                for (int n = 0; n < 2; ++n) acc[a][b][m][n] = (f32x4){0.f, 0.f, 0.f, 0.f};
    bf16x8 At[4][2], B0[2][2], B1[2][2];
    const char* cA = (const char*)cur.a + (GATHER ? (size_t)0 : (size_t)cur.pm * 2 * hstepA); const char* cB = (const char*)cur.bt + (size_t)cur.pn * 2 * hstepB;
    PG_STAGE_B(PG_SB(0, 0), cB); PG_STAGE_B(PG_SB(0, 1), cB + hstepB); PG_STAGE_A(PG_SA(0, 0), cA, 0, false); PG_STAGE_A(PG_SA(0, 1), cA, 1, false);
    if (wr == 1) PG_BAR;
    PG_WAIT_V(2); PG_BAR;
    PG_STAGE_B(PG_SB(1, 0), cB + kstep); PG_STAGE_A(PG_SA(1, 0), cA + kstep, 0, false); PG_STAGE_B(PG_SB(1, 1), cB + hstepB + kstep);
    PG_WAIT_V(6); PG_BAR;
    for (;;) {
        const bool has_next = S.next(ui + 1, nxt);
        const char* nA = has_next ? (const char*)nxt.a + (GATHER ? (size_t)0 : (size_t)nxt.pm * 2 * hstepA) : cA; const char* nB = has_next ? (const char*)nxt.bt + (size_t)nxt.pn * 2 * hstepB : cB;
        if constexpr (GATHER) {
            if (has_next) {
#pragma unroll
                for (int h = 0; h < 2; ++h)
#pragma unroll
                    for (int i = 0; i < 2; ++i) nOff[h][i] = (unsigned)(gather[nxt.pm * 256 + h * 128 + R0 + 64 * i] * lda + C0) * 2u;
            } else {
#pragma unroll
                for (int h = 0; h < 2; ++h)
#pragma unroll
                    for (int i = 0; i < 2; ++i) nOff[h][i] = cOff[h][i];
            }
        }
        for (int t = 0; t < nt; t += 2) {
            const bool last = (t == nt - 2);
            const char* a1 = cA + (size_t)(t + 1) * kstep;
            const char* a2 = last ? nA : cA + (size_t)(t + 2) * kstep; const char* b2 = last ? nB : cB + (size_t)(t + 2) * kstep;
            const char* a3 = a2 + kstep; const char* b3 = b2 + kstep;
            PG_LDB(B0, 0, 0); PG_LDB(B1, 0, 1); PG_SCHED; PG_LDA(At, 0, 0); PG_STAGE_A(PG_SA(1, 1), a1, 1, false);
            PG_WAIT_V(8); PG_WAIT_L(0); PG_BAR; PG_MMA(0, 0, At, B0); PG_MMA(0, 1, At, B1); PG_BAR; PG_SCHED;
            PG_LDA(At, 0, 1); PG_STAGE_B(PG_SB(0, 0), b2); PG_STAGE_B(PG_SB(0, 1), b2 + hstepB); PG_STAGE_A(PG_SA(0, 0), a2, 0, last);
            PG_WAIT_V(8); PG_WAIT_L(0); PG_BAR; PG_MMA(1, 0, At, B0); PG_MMA(1, 1, At, B1); PG_BAR; PG_SCHED;
            PG_LDB(B0, 1, 0); PG_LDB(B1, 1, 1); PG_SCHED; PG_LDA(At, 1, 0); PG_STAGE_A(PG_SA(0, 1), a2, 1, last);
            PG_WAIT_V(8); PG_WAIT_L(0); PG_BAR; PG_MMA(0, 0, At, B0); PG_MMA(0, 1, At, B1); PG_BAR; PG_SCHED;
            PG_LDA(At, 1, 1); PG_STAGE_B(PG_SB(1, 0), b3); PG_STAGE_B(PG_SB(1, 1), b3 + hstepB); PG_STAGE_A(PG_SA(1, 0), a3, 0, last);
            PG_WAIT_V(8); PG_WAIT_L(0); PG_BAR; PG_MMA(1, 0, At, B0); PG_MMA(1, 1, At, B1); PG_BAR; PG_SCHED;
            if constexpr (Hook::ON) { if (((t + 2) & 7) == 0) H.apply(acc, (t + 2) / 8 - 1, wr, fr); }
        }
        if constexpr (ALIGN_EPI) { if (wr == 0) PG_BAR; }
        run_epi(E, acc, cur, wr, wc, fr, fq);
        if (!has_next) break;
#pragma unroll
        for (int a = 0; a < 2; ++a)
#pragma unroll
            for (int b = 0; b < 2; ++b)
#pragma unroll
                for (int m = 0; m < 4; ++m)
#pragma unroll
                    for (int n = 0; n < 2; ++n) acc[a][b][m][n] = (f32x4){0.f, 0.f, 0.f, 0.f};
        cur = nxt; cA = nA; cB = nB; ++ui;
        if constexpr (GATHER) {
#pragma unroll
            for (int h = 0; h < 2; ++h)
#pragma unroll
                for (int i = 0; i < 2; ++i) cOff[h][i] = nOff[h][i];
        }
        if constexpr (ALIGN_EPI) { if (wr == 1) PG_BAR; }
    }
    PG_WAIT_V(0);
    if constexpr (!ALIGN_EPI) { if (wr == 0) PG_BAR; }
    PG_BAR;
#undef PG_SA
#undef PG_SB
#undef PG_GLDS
#undef PG_STAGE_A
#undef PG_STAGE_B
#undef PG_LDA
#undef PG_LDB
#undef PG_MMA
#undef PG_WAIT_V
#undef PG_WAIT_L
#undef PG_BAR
#undef PG_SCHED
}
}

struct DenseOrder {
    int nM, nN, nwg, G, c; const bf16* a; const bf16* bt;
    __device__ __forceinline__ bool next(int i, GUnit& u) const {
        const int L = i * G + c; if (L >= nwg) return false;
        int wgid = L; { const int q = nwg / 8, r = nwg % 8, xcd = wgid % 8, off = wgid / 8; wgid = (xcd < r ? xcd * (q + 1) : r * (q + 1) + (xcd - r) * q) + off; }
        const int nig = 8 * nN, gid = wgid / nig, fm = gid * 8, gsz = (nM - fm) < 8 ? (nM - fm) : 8;
        u.pm = fm + ((wgid % nig) % gsz); u.pn = (wgid % nig) / gsz; u.e = 0; u.a = a; u.bt = bt; return true;
    } };
struct PoolOrder { int G, c; const bf16* PO; const bf16* WPOOL;
    __device__ __forceinline__ bool next(int i, GUnit& u) const { const int L = i * G + c; if (L >= 256) return false; u.pm = L >> 2; u.pn = 0; u.e = L & 3; u.a = PO + 256 * u.e; u.bt = WPOOL + (size_t)u.e * 65536; return true; } };
template <int NCOL, int BROWS> struct MoeOrder { int G, c, nrt; const int* tile_e; const bf16* a; const bf16* w;
    __device__ __forceinline__ bool next(int i, GUnit& u) const { const int L = i * G + c; if (L >= nrt * NCOL) return false; u.pm = L / NCOL; u.pn = L % NCOL; u.e = tile_e[u.pm]; u.a = a; u.bt = w + (size_t)u.e * BROWS * 1024; return true; } };
struct NoHookPg { static constexpr bool ON = false; __device__ __forceinline__ void apply(f32x4 (&)[2][2][4][2], int, int, int) const {} };
struct RatioHook { static constexpr bool ON = true; const LAS float* tab;
    __device__ __forceinline__ void apply(f32x4 (&acc)[2][2][4][2], int g, int wr, int fr) const {
#pragma unroll
        for (int ai = 0; ai < 2; ++ai)
#pragma unroll
            for (int m = 0; m < 4; ++m) { const float r = tab[(ai * 128 + wr * 64 + m * 16 + fr) * 4 + g];
#pragma unroll
                for (int bj = 0; bj < 2; ++bj)
#pragma unroll
                    for (int n = 0; n < 2; ++n) acc[ai][bj][m][n] *= r; }
    } };

struct EpiInproj { static constexpr bool PAIR = false; bf16 *Z, *XBC, *U, *GT;
    __device__ __forceinline__ void operator()(const GUnit&, int row, int col, f32x4 lo, f32x4 hi) const {
        if (col < 2048) { for (int i = 0; i < 4; ++i) { lo[i] = siluf_(lo[i]); hi[i] = siluf_(hi[i]); } *(u32x4*)(Z + (size_t)row * 2048 + col) = pack8(lo, hi); }
        else if (col < 5120) *(u32x4*)(XBC + (size_t)row * 3072 + (col - 2048)) = pack8(lo, hi);
        else if (col < 6144) *(u32x4*)(U + (size_t)row * 1024 + (col - 5120)) = pack8(lo, hi);
        else { for (int i = 0; i < 4; ++i) { lo[i] = sigmoidf_(lo[i]); hi[i] = sigmoidf_(hi[i]); } *(u32x4*)(GT + (size_t)row * 2048 + (col - 6144)) = pack8(lo, hi); }
    } };
struct EpiPool { static constexpr bool PAIR = false; bf16* YPG; const bf16* GT;
    __device__ __forceinline__ void operator()(const GUnit& u, int row, int col, f32x4 lo, f32x4 hi) const {
        const int c = u.e * 256 + col; float g[8]; unpack8(*(const u32x4*)(GT + (size_t)row * 2048 + 1024 + c), g);
        for (int i = 0; i < 4; ++i) { lo[i] *= g[i]; hi[i] *= g[4 + i]; }
        *(u32x4*)(YPG + (size_t)row * 1024 + c) = pack8(lo, hi);
    } };
struct EpiOut { static constexpr bool PAIR = false; bf16* MIXED; const bf16 *GT, *YPG;
    __device__ __forceinline__ void operator()(const GUnit&, int row, int col, f32x4 lo, f32x4 hi) const {
        float g[8], y[8]; unpack8(*(const u32x4*)(GT + (size_t)row * 2048 + col), g); unpack8(*(const u32x4*)(YPG + (size_t)row * 1024 + col), y);
        for (int i = 0; i < 4; ++i) { lo[i] = lo[i] * g[i] + y[i]; hi[i] = hi[i] * g[4 + i] + y[4 + i]; }
        *(u32x4*)(MIXED + (size_t)row * 1024 + col) = pack8(lo, hi);
    } };
struct EpiMix { static constexpr bool PAIR = false; const float* x; float* X1;
    __device__ __forceinline__ void operator()(const GUnit&, int row, int col, f32x4 lo, f32x4 hi) const {
        const f32x4 a = *(const f32x4*)(x + (size_t)row * 1024 + col), b = *(const f32x4*)(x + (size_t)row * 1024 + col + 4);
        *(f32x4*)(X1 + (size_t)row * 1024 + col) = a + lo; *(f32x4*)(X1 + (size_t)row * 1024 + col + 4) = b + hi;
    } };
struct EpiGU { static constexpr bool PAIR = true; bf16* ACT; const float* b_gate_up;
    __device__ __forceinline__ void pair(const GUnit& u, int row, int colh, f32x4 g0, f32x4 g1, f32x4 u0, f32x4 u1) const {
        const int c = u.pn * 128 + colh; const float* bg = b_gate_up + (size_t)u.e * 2048 + c;
        const f32x4 bg0 = *(const f32x4*)bg, bg1 = *(const f32x4*)(bg + 4), bu0 = *(const f32x4*)(bg + 1024), bu1 = *(const f32x4*)(bg + 1028);
        f32x4 lo, hi;
        for (int i = 0; i < 4; ++i) {
            float ga = fminf(g0[i] + bg0[i], 7.f), up = fminf(fmaxf(u0[i] + bu0[i], -7.f), 7.f); lo[i] = (up + 1.f) * ga * sigmoidf_(1.702f * ga);
            ga = fminf(g1[i] + bg1[i], 7.f); up = fminf(fmaxf(u1[i] + bu1[i], -7.f), 7.f); hi[i] = (up + 1.f) * ga * sigmoidf_(1.702f * ga); }
        *(u32x4*)(ACT + (size_t)row * 1024 + c) = pack8(lo, hi);
    } };
struct EpiDN { static constexpr bool PAIR = false; bf16* YR; const float* b_down;
    __device__ __forceinline__ void operator()(const GUnit& u, int row, int col, f32x4 lo, f32x4 hi) const {
        const float* b = b_down + (size_t)u.e * 1024 + col; lo += *(const f32x4*)b; hi += *(const f32x4*)(b + 4);
        *(u32x4*)(YR + (size_t)row * 1024 + col) = pack8(lo, hi);
    } };
struct EpiF32 { static constexpr bool PAIR = false; float* C;
    __device__ __forceinline__ void operator()(const GUnit&, int row, int col, f32x4 lo, f32x4 hi) const { *(f32x4*)(C + (size_t)row * 1024 + col) = lo; *(f32x4*)(C + (size_t)row * 1024 + col + 4) = hi; } };
struct EpiPle { static constexpr bool PAIR = false; const float* TMP; float* X;
    __device__ __forceinline__ void operator()(const GUnit&, int row, int col, f32x4 lo, f32x4 hi) const {
        float* xp = X + (size_t)row * 1024 + col; const float* tp = TMP + (size_t)row * 1024 + col;
        const f32x4 t0 = *(const f32x4*)tp, t1 = *(const f32x4*)(tp + 4); f32x4 x0 = *(const f32x4*)xp, x1 = *(const f32x4*)(xp + 4);
        for (int i = 0; i < 4; ++i) { x0[i] += sigmoidf_(lo[i]) * t0[i]; x1[i] += sigmoidf_(hi[i]) * t1[i]; }
        *(f32x4*)xp = x0; *(f32x4*)(xp + 4) = x1;
    } };

__device__ __forceinline__ void tr_item(const float* W, int ldw, int n0src, int k0, bf16* WT, int K, int dstrow0, const float* kscale, const float* nscale, LAS float* scr, int lane) {
#pragma unroll 8
    for (int i = 0; i < 32; ++i) { const int kk = 2 * i + (lane >> 5); float v = W[(size_t)(k0 + kk) * ldw + n0src + (lane & 31)];
        if (kscale) v *= kscale[k0 + kk]; if (nscale) v *= nscale[n0src + (lane & 31)]; scr[kk * 33 + (lane & 31)] = v; }
    asm volatile("s_waitcnt lgkmcnt(0)" ::: "memory");
    const int c = lane & 7;
#pragma unroll
    for (int j = 0; j < 4; ++j) { const int n = (lane >> 3) + 8 * j; const LAS float* s = scr + (8 * c) * 33 + n;
        u32x4 o; o.x = pk2(s[0 * 33], s[1 * 33]); o.y = pk2(s[2 * 33], s[3 * 33]); o.z = pk2(s[4 * 33], s[5 * 33]); o.w = pk2(s[6 * 33], s[7 * 33]);
        *(u32x4*)(WT + (size_t)(dstrow0 + n) * K + k0 + 8 * c) = o; }
    asm volatile("s_waitcnt lgkmcnt(0)" ::: "memory");
}
__device__ __forceinline__ void p0_prologue(const Frame& F) {
    LAS float* scr = (LAS float*)(F.lds + F.wave * 16384);
    const int gw = F.wg * NWAVES + F.wave, NGW = F.G * NWAVES, lane = F.lane;
    constexpr int I_WIN = 16 * 257, I_WOUT = 32 * 32, I_WPOOL = 4 * 4 * 8, I_WMIX = 16 * 32, I_WPG = 16 * 32, I_WPP = 4 * 32, I_WGU = 32 * 16 * 64, I_WDN = 32 * 16 * 32;
    constexpr int NITEMS = I_WIN + I_WOUT + I_WPOOL + I_WMIX + I_WPG + I_WPP + I_WGU + I_WDN;
#pragma unroll 1
    for (int it = gw; it < NITEMS; it += NGW) {
        int r = it;
        if (r < I_WIN) { const int kb = r / 257, nb = r % 257; if (nb != 160) tr_item(F.w_in, NPROJ, 32 * nb, 64 * kb, F.WIN, 1024, 32 * nb - (nb > 160 ? 32 : 0), nullptr, nullptr, scr, lane); continue; } r -= I_WIN;
        if (r < I_WOUT) { const int kb = r / 32, nb = r % 32; tr_item(F.w_ssd_out, 1024, 32 * nb, 64 * kb, F.WOUT, 2048, 32 * nb, F.ssd_norm_g, nullptr, scr, lane); continue; } r -= I_WOUT;
        if (r < I_WPOOL) { const int g = r / 32, q = r % 32, kb = q / 8, nb = q % 8; tr_item(F.pool_w + (size_t)g * 65536, 256, 32 * nb, 64 * kb, F.WPOOL + (size_t)g * 65536, 256, 32 * nb, nullptr, F.pool_scale + g * 256, scr, lane); continue; } r -= I_WPOOL;
        if (r < I_WMIX) { const int kb = r / 32, nb = r % 32; tr_item(F.w_mix_out, 1024, 32 * nb, 64 * kb, F.WMIX, 1024, 32 * nb, nullptr, nullptr, scr, lane); continue; } r -= I_WMIX;
        if (r < I_WPG) { const int kb = r / 32, nb = r % 32; tr_item(F.w_ple_gate, 1024, 32 * nb, 64 * kb, F.WPG, 1024, 32 * nb, nullptr, nullptr, scr, lane); continue; } r -= I_WPG;
        if (r < I_WPP) { const int kb = r / 32, nb = r % 32; tr_item(F.w_ple_proj, 1024, 32 * nb, 64 * kb, F.WPP, 256, 32 * nb, nullptr, nullptr, scr, lane); continue; } r -= I_WPP;
        if (r < I_WGU) { const int e = r / 1024, q = r % 1024, kb = q / 64, nb = q % 64; const int c = 32 * nb, s = c >> 10, rr = c & 1023, dst = 256 * (rr >> 7) + 128 * s + (rr & 127);
            tr_item(F.w_gate_up + (size_t)e * 1024 * 2048, 2048, c, 64 * kb, F.WGU + (size_t)e * 2048 * 1024, 1024, dst, nullptr, nullptr, scr, lane); continue; } r -= I_WGU;
        { const int e = r / 512, q = r % 512, kb = q / 32, nb = q % 32; tr_item(F.w_down + (size_t)e * 1024 * 1024, 1024, 32 * nb, 64 * kb, F.WDN + (size_t)e * 1024 * 1024, 1024, 32 * nb, nullptr, nullptr, scr, lane); }
    }
#pragma unroll 1
    for (int row = gw; row < T; row += NGW) {
        const f32x4* xr = (const f32x4*)(F.x + (size_t)row * D) + lane;
        f32x4 v[4]; float s = 0.f;
#pragma unroll
        for (int j = 0; j < 4; ++j) { v[j] = xr[64 * j]; s += (v[j][0] * v[j][0] + v[j][1] * v[j][1]) + (v[j][2] * v[j][2] + v[j][3] * v[j][3]); }
        const float rs = rsqrtf(wave_sum(s) * (1.f / D) + EPS);
        u32x2* o8 = (u32x2*)(F.XN + (size_t)row * D) + lane;
#pragma unroll
        for (int j = 0; j < 4; ++j) { const f32x4 g = ((const f32x4*)F.mix_norm_g)[lane + 64 * j]; v[j] = v[j] * rs * g; u32x2 w; w.x = pk2(v[j][0], v[j][1]); w.y = pk2(v[j][2], v[j][3]); o8[64 * j] = w; }
        float mydt = 0.f;
#pragma unroll 1
        for (int e = 0; e < 32; ++e) { float pa = 0.f;
#pragma unroll
            for (int j = 0; j < 4; ++j)
#pragma unroll
                for (int i = 0; i < 4; ++i) pa = fmaf(v[j][i], F.w_in[(size_t)(4 * lane + 256 * j + i) * NPROJ + 5120 + e], pa);
            pa = wave_sum(pa); if (lane == e) mydt = pa; }
        if (lane < 32) { const float dtr = mydt + F.dt_bias[lane]; F.DT[(size_t)row * 32 + lane] = dtr > 20.f ? dtr : log1pf(__expf(dtr)); }
    }
    const size_t n8 = (size_t)T * DPLE / 8;
#pragma unroll 1
    for (size_t i = (size_t)F.wg * NTHREADS + F.tid; i < n8; i += (size_t)F.G * NTHREADS) { const f32x4 a = ((const f32x4*)F.p)[2 * i], b = ((const f32x4*)F.p)[2 * i + 1]; ((u32x4*)F.PB)[i] = pack8(a, b); }
}

template <class Epi, class Hook>
__device__ __forceinline__ void dense_gemm_phase(const Frame& F, const bf16* A, int lda, const bf16* Bt, int K, int nM, int nN, const Epi& E, const Hook& H) {
#pragma unroll 1
    for (int ui = F.wg; ui < nM * nN; ui += F.G) { GUnit u; u.pm = ui / nN; u.pn = ui % nN; u.e = 0; u.a = A; u.bt = Bt; sgemm_unit(u, lda, K, nullptr, E, H, F.wave, F.lane); }
}

__device__ __forceinline__ void p2_pool(const Frame& F) {
    const size_t n8 = (size_t)T * 1024 / 8;
#pragma unroll 1
    for (size_t i = (size_t)F.wg * NTHREADS + F.tid; i < n8; i += (size_t)F.G * NTHREADS) {
        const int t = (int)(i >> 7), c = (int)(i & 127) * 8, gi = c >> 8, w = 2 << gi, pos = t % SEQ, cnt = (pos + 1 < w) ? pos + 1 : w;
        float s[8] = {0, 0, 0, 0, 0, 0, 0, 0}, u0[8] = {0, 0, 0, 0, 0, 0, 0, 0};
#pragma unroll 1
        for (int j = 0; j < cnt; ++j) { float f[8]; unpack8(*(const u32x4*)(F.U + (size_t)(t - j) * 1024 + c), f);
#pragma unroll
            for (int q = 0; q < 8; ++q) { s[q] += f[q]; if (j == 0) u0[q] = f[q]; } }
        const float inv = 1.f / (float)cnt; f32x4 lo, hi;
#pragma unroll
        for (int q = 0; q < 4; ++q) { lo[q] = s[q] * inv - u0[q]; hi[q] = s[4 + q] * inv - u0[4 + q]; }
        *(u32x4*)(F.PO + (size_t)t * 1024 + c) = pack8(lo, hi);
    }
}
__device__ __forceinline__ void p2_ssd_naive(const Frame& F) {
    LAS float* sx = (LAS float*)F.lds; LAS float* sB = sx + 128; LAS float* sC = sB + 256; LAS float* sq = sC + 256;
    const int tid = F.tid;
#pragma unroll 1
    for (int unit = F.wg; unit < NB * NH; unit += F.G) {
        const int b = unit / NH, h = unit % NH, g = h / 8, p = tid >> 3, nb = tid & 7;
        int cch = -1;
        if (tid < 64) cch = h * 64 + tid; else if (tid < 192) cch = 2048 + g * 128 + (tid - 64); else if (tid < 320) cch = 2560 + g * 128 + (tid - 192);
        float w0 = 0, w1 = 0, w2 = 0, w3 = 0, cb = 0;
        if (cch >= 0) { w0 = F.conv_w[cch]; w1 = F.conv_w[DCONV + cch]; w2 = F.conv_w[2 * DCONV + cch]; w3 = F.conv_w[3 * DCONV + cch]; cb = F.conv_b[cch]; }
        const float a = -__expf(F.a_log[h]), dsk = F.d_skip[h];
        float st[16];
#pragma unroll
        for (int i = 0; i < 16; ++i) st[i] = 0.f;
        float x1 = 0.f, x2 = 0.f, x3 = 0.f;
        __syncthreads();
#pragma unroll 1
        for (int t = 0; t < SEQ; ++t) {
            const size_t row = (size_t)(b * SEQ + t); const int buf = t & 1;
            if (cch >= 0) {
                const float x0 = bf2f(F.XBC[row * DCONV + cch]);
                float v = cb + w3 * x0 + w2 * x1 + w1 * x2 + w0 * x3; x3 = x2; x2 = x1; x1 = x0; v = siluf_(v);
                if (tid < 64) sx[buf * 64 + tid] = v; else if (tid < 192) sB[buf * 128 + tid - 64] = v; else sC[buf * 128 + tid - 192] = v;
            }
            const float dt = F.DT[row * 32 + h], dA = __expf(dt * a);
            __syncthreads();
            const float xv = sx[buf * 64 + p], dx = dt * xv; float y = 0.f;
#pragma unroll
            for (int i = 0; i < 16; ++i) { st[i] = st[i] * dA + dx * sB[buf * 128 + nb * 16 + i]; y = fmaf(sC[buf * 128 + nb * 16 + i], st[i], y); }
            y += __shfl_xor(y, 1); y += __shfl_xor(y, 2); y += __shfl_xor(y, 4);
            if (nb == 0) { const float v = (y + dsk * xv) * bf2f(F.Z[row * DIN + h * 64 + p]); F.V[row * DIN + h * 64 + p] = (bf16)f2bf(v); sq[p] = v * v; }
            __syncthreads();
            if (tid < 64) { const float ssum = wave_sum(sq[tid]); if (tid == 0) F.SS[row * 32 + h] = ssum; }
        }
        __syncthreads();
    }
}
__device__ __forceinline__ void p3_rstd(const Frame& F) {
#pragma unroll 1
    for (int t = F.wg * NTHREADS + F.tid; t < T; t += F.G * NTHREADS) { float r[4];
#pragma unroll
        for (int g = 0; g < 4; ++g) { float s = 0.f;
#pragma unroll
            for (int q = 0; q < 8; ++q) s += F.SS[(size_t)t * 32 + g * 8 + q];
            r[g] = rsqrtf(s * (1.f / 512.f) + EPS); }
        *(f32x4*)(F.RSTD + (size_t)t * 4) = (f32x4){r[0] / r[1], r[1] / r[2], r[2] / r[3], r[3]}; }
}
__device__ __forceinline__ void p6_router(const Frame& F) {
    LAS int* cnt = (LAS int*)F.lds;
    if (F.tid < 32) cnt[F.tid] = 0;
    __syncthreads();
    const int lane = F.lane;
#pragma unroll 1
    for (int rr = 0; rr < 8; ++rr) {
        const int row = F.wg * 64 + F.wave * 8 + rr;
        const f32x4* xr = (const f32x4*)(F.out + (size_t)row * D) + lane;
        f32x4 v[4]; float s = 0.f;
#pragma unroll
        for (int j = 0; j < 4; ++j) { v[j] = xr[64 * j]; s += (v[j][0] * v[j][0] + v[j][1] * v[j][1]) + (v[j][2] * v[j][2] + v[j][3] * v[j][3]); }
        const float rs = rsqrtf(wave_sum(s) * (1.f / D) + EPS);
        u32x2* o8 = (u32x2*)(F.XN + (size_t)row * D) + lane;
#pragma unroll
        for (int j = 0; j < 4; ++j) { const f32x4 g = ((const f32x4*)F.ffn_norm_g)[lane + 64 * j]; v[j] = v[j] * rs * g; u32x2 w; w.x = pk2(v[j][0], v[j][1]); w.y = pk2(v[j][2], v[j][3]); o8[64 * j] = w; }
        LAS float* rowbuf = (LAS float*)(F.lds + 1024 + F.wave * 4096);
#pragma unroll
        for (int j = 0; j < 4; ++j) *(LAS f32x4*)(rowbuf + 4 * (lane + 64 * j)) = v[j];
        asm volatile("s_waitcnt lgkmcnt(0)" ::: "memory");
        float lg[32];
#pragma unroll
        for (int e = 0; e < 32; ++e) lg[e] = 0.f;
#pragma unroll 1
        for (int kk = 0; kk < 16; ++kk) { const int k = lane + 64 * kk; const float xv = rowbuf[k]; const f32x4* wr = (const f32x4*)(F.w_router + (size_t)k * 32);
#pragma unroll
            for (int q = 0; q < 8; ++q) { const f32x4 w = wr[q]; lg[4 * q] = fmaf(xv, w[0], lg[4 * q]); lg[4 * q + 1] = fmaf(xv, w[1], lg[4 * q + 1]); lg[4 * q + 2] = fmaf(xv, w[2], lg[4 * q + 2]); lg[4 * q + 3] = fmaf(xv, w[3], lg[4 * q + 3]); } }
#pragma unroll
        for (int e = 0; e < 32; ++e) lg[e] = wave_sum(lg[e]) + F.b_router[e];
        float tv[4]; int ti[4];
#pragma unroll
        for (int k = 0; k < 4; ++k) { float best = -INFINITY; int bi = 0;
#pragma unroll
            for (int e = 0; e < 32; ++e) if (lg[e] > best) { best = lg[e]; bi = e; }
            tv[k] = best; ti[k] = bi;
#pragma unroll
            for (int e = 0; e < 32; ++e) if (e == bi) lg[e] = -INFINITY; }
        float ex[4], se = 0.f;
#pragma unroll
        for (int k = 0; k < 4; ++k) { ex[k] = __expf(tv[k] - tv[0]); se += ex[k]; }
        if (lane == 0) {
#pragma unroll
            for (int k = 0; k < 4; ++k) { F.TIDX[row * 4 + k] = ti[k]; F.TW[row * 4 + k] = ex[k] / se; __hip_atomic_fetch_add(cnt + ti[k], 1, __ATOMIC_RELAXED, __HIP_MEMORY_SCOPE_WORKGROUP); } }
    }
    __syncthreads();
    if (F.tid < 32) F.CNT[F.wg * 32 + F.tid] = cnt[F.tid];
}
__device__ __forceinline__ void p7_route(const Frame& F) {
    LAS int* base = (LAS int*)F.lds; LAS int* tot = base + 32; LAS int* pstart = tot + 32; LAS int* earr = pstart + 64;
    const int tid = F.tid;
    if (tid < 32) { int tt = 0, bb = 0;
#pragma unroll 1
        for (int w = 0; w < 256; ++w) { const int c = F.CNT[w * 32 + tid]; tt += c; if (w < F.wg) bb += c; }
        tot[tid] = tt; base[tid] = bb; }
    if (tid < 256) earr[tid] = F.TIDX[F.wg * 256 + tid];
    __syncthreads();
    if (tid == 0) { int s = 0;
#pragma unroll 1
        for (int e = 0; e < 32; ++e) { pstart[e] = s; s += (tot[e] + 255) / 256 * 256; } pstart[32] = s; }
    __syncthreads();
    if (tid < 256) { const int e = earr[tid]; int lr = 0;
#pragma unroll 1
        for (int j = 0; j < tid; ++j) lr += (earr[j] == e) ? 1 : 0;
        const int d = pstart[e] + base[e] + lr; F.DEST[F.wg * 256 + tid] = d; F.ROWTOK[d] = F.wg * 64 + (tid >> 2); }
    if (F.wg < 32) { const int e = F.wg;
#pragma unroll 1
        for (int r = pstart[e] + tot[e] + tid; r < pstart[e + 1]; r += NTHREADS) F.ROWTOK[r] = 0; }
    if (F.wg == 0 && tid < 33) F.PSTART[tid] = pstart[tid];
    if (F.wg == 0 && tid < MAXROWS / 256) { int e = 0;
#pragma unroll 1
        for (int q = 1; q < 32; ++q) if (tid * 256 >= pstart[q]) e = q;
        F.TILE_E[tid] = e; }
}
__device__ __forceinline__ int expert_of_row(const int* ps, int row) { int e = 0;
#pragma unroll 1
    for (int q = 1; q < 32; ++q) if (row >= ps[q]) e = q;
    return e; }
__device__ __forceinline__ void p8_moe_gu(const Frame& F) {
    const int nrt = F.PSTART[32] / 256; const EpiGU E{F.ACT, F.b_gate_up}; const NoHook H;
#pragma unroll 1
    for (int ui = F.wg; ui < nrt * 8; ui += F.G) { GUnit u; u.pm = ui >> 3; u.pn = ui & 7; u.e = expert_of_row(F.PSTART, u.pm * 256); u.a = F.XN; u.bt = F.WGU + (size_t)u.e * 2048 * 1024;
        sgemm_unit(u, 1024, 1024, F.ROWTOK, E, H, F.wave, F.lane); }
}
__device__ __forceinline__ void p9_moe_dn(const Frame& F) {
    const int nrt = F.PSTART[32] / 256; const EpiDN E{F.YR, F.b_down}; const NoHook H;
#pragma unroll 1
    for (int ui = F.wg; ui < nrt * 4; ui += F.G) { GUnit u; u.pm = ui >> 2; u.pn = ui & 3; u.e = expert_of_row(F.PSTART, u.pm * 256); u.a = F.ACT; u.bt = F.WDN + (size_t)u.e * 1024 * 1024;
        sgemm_unit(u, 1024, 1024, nullptr, E, H, F.wave, F.lane); }
}
__device__ __forceinline__ void p10_combine(const Frame& F) {
    const int gw = F.wg * NWAVES + F.wave, NGW = F.G * NWAVES, lane = F.lane;
#pragma unroll 1
    for (int row = gw; row < T; row += NGW) {
        f32x4* xr = (f32x4*)(F.out + (size_t)row * D) + lane;
        f32x4 v[4];
#pragma unroll
        for (int j = 0; j < 4; ++j) v[j] = xr[64 * j];
#pragma unroll
        for (int k = 0; k < 4; ++k) { const int d = F.DEST[row * 4 + k]; const float w = F.TW[row * 4 + k]; const u32x2* yr = (const u32x2*)(F.YR + (size_t)d * 1024) + lane;
#pragma unroll
            for (int j = 0; j < 4; ++j) { const u32x2 q = yr[64 * j]; v[j][0] += w * bf2f(q.x & 0xffffu); v[j][1] += w * bf2f(q.x >> 16); v[j][2] += w * bf2f(q.y & 0xffffu); v[j][3] += w * bf2f(q.y >> 16); } }
        float s = 0.f;
#pragma unroll
        for (int j = 0; j < 4; ++j) { xr[64 * j] = v[j]; s += (v[j][0] * v[j][0] + v[j][1] * v[j][1]) + (v[j][2] * v[j][2] + v[j][3] * v[j][3]); }
        const float rs = rsqrtf(wave_sum(s) * (1.f / D) + EPS);
        u32x2* o8 = (u32x2*)(F.XN + (size_t)row * D) + lane;
#pragma unroll
        for (int j = 0; j < 4; ++j) { const f32x4 g = ((const f32x4*)F.ple_norm_g)[lane + 64 * j]; const f32x4 q = v[j] * rs * g; u32x2 w; w.x = pk2(q[0], q[1]); w.y = pk2(q[2], q[3]); o8[64 * j] = w; }
    }
}
__device__ __forceinline__ void p12_final(const Frame& F) {
    const int gw = F.wg * NWAVES + F.wave, NGW = F.G * NWAVES, lane = F.lane;
#pragma unroll 1
    for (int row = gw; row < T; row += NGW) {
        f32x4* xr = (f32x4*)(F.out + (size_t)row * D) + lane; f32x4 v[4]; float s = 0.f;
#pragma unroll
        for (int j = 0; j < 4; ++j) { v[j] = xr[64 * j]; s += (v[j][0] * v[j][0] + v[j][1] * v[j][1]) + (v[j][2] * v[j][2] + v[j][3] * v[j][3]); }
        const float rs = rsqrtf(wave_sum(s) * (1.f / D) + EPS);
#pragma unroll
        for (int j = 0; j < 4; ++j) { const f32x4 g = ((const f32x4*)F.final_norm_g)[lane + 64 * j]; xr[64 * j] = v[j] * rs * g; }
    }
}

constexpr int LDS_BYTES = 147456;

__global__ void __launch_bounds__(NTHREADS, 2) mk_fwd(Args args) {
    extern __shared__ __attribute__((aligned(16))) unsigned char lds_raw[];
    Frame F;
    F.lds = (LAS unsigned char*)lds_raw; F.tid = threadIdx.x; F.lane = F.tid & 63; F.wave = __builtin_amdgcn_readfirstlane(F.tid >> 6); F.G = gridDim.x; F.wg = blockIdx.x;
    unsigned char* ws = args.ws;
    F.x = args.in[0]; F.p = args.in[1]; F.mix_norm_g = args.in[2]; F.w_in = args.in[3]; F.conv_w = args.in[4]; F.conv_b = args.in[5]; F.dt_bias = args.in[6]; F.a_log = args.in[7]; F.d_skip = args.in[8];
    F.ssd_norm_g = args.in[9]; F.w_ssd_out = args.in[10]; F.pool_w = args.in[11]; F.pool_scale = args.in[12]; F.w_mix_out = args.in[13]; F.ffn_norm_g = args.in[14]; F.w_router = args.in[15];
    F.b_router = args.in[16]; F.w_gate_up = args.in[17]; F.b_gate_up = args.in[18]; F.w_down = args.in[19]; F.b_down = args.in[20]; F.ple_norm_g = args.in[21]; F.w_ple_gate = args.in[22];
    F.w_ple_proj = args.in[23]; F.final_norm_g = args.in[24]; F.out = args.out;
    F.WIN = (bf16*)(ws + WS_WIN); F.WOUT = (bf16*)(ws + WS_WOUT); F.WPOOL = (bf16*)(ws + WS_WPOOL); F.WMIX = (bf16*)(ws + WS_WMIX); F.WPG = (bf16*)(ws + WS_WPG); F.WPP = (bf16*)(ws + WS_WPP);
    F.WGU = (bf16*)(ws + WS_WGU); F.WDN = (bf16*)(ws + WS_WDN); F.XN = (bf16*)(ws + WS_XN); F.PO = (bf16*)(ws + WS_PO); F.YPG = (bf16*)(ws + WS_YPG); F.MIXED = (bf16*)(ws + WS_MIXED);
    F.PB = (bf16*)(ws + WS_PB); F.Z = (bf16*)(ws + WS_Z); F.XBC = (bf16*)(ws + WS_XBC); F.U = (bf16*)(ws + WS_U); F.GT = (bf16*)(ws + WS_GT); F.V = (bf16*)(ws + WS_V);
    F.ACT = (bf16*)(ws + WS_ACT); F.YR = (bf16*)(ws + WS_YR); F.DT = (float*)(ws + WS_DT); F.SS = (float*)(ws + WS_SS); F.RSTD = (float*)(ws + WS_RSTD); F.TMP = (float*)(ws + WS_TMP);
    { unsigned char* r = ws + WS_ROUTE; F.TIDX = (int*)r; r += NA * 4; F.TW = (float*)r; r += NA * 4; F.DEST = (int*)r; r += NA * 4; F.ROWTOK = (int*)r; r += MAXROWS * 4; F.CNT = (int*)r; r += 256 * 32 * 4; F.PSTART = (int*)r; r += 256; F.TILE_E = (int*)r; }

    volatile LAS unsigned* MISC = (volatile LAS unsigned*)(F.lds + 131072);
    if (F.tid < 64) MISC[F.tid] = 0u;
    __syncthreads();
    const int lo = args.ph_lo, hi = args.ph_hi;
    XcdBarrier bar; bar.bar = (unsigned*)(ws + WS_CTL) + CW_BAR; bar.x = 0; bar.st = nullptr;
    if (hi - lo > 1) bar = xcd_barrier_post((unsigned*)(ws + WS_CTL) + CW_BAR, MISC + 8);
#define IN(k) (lo <= (k) && (k) < hi)
#define SEAM(k) do { if (IN(k) && IN((k) + 1)) xcd_barrier(bar); } while (0)
    const NoHook NH_; const NoHookPg NHP;
    LAS unsigned char* ring = F.lds;
#define PG(k) ((PGMASK >> (k)) & 1)
    if (IN(0)) { p0_prologue(F); } SEAM(0);
    if (IN(1)) { const EpiInproj E{F.Z, F.XBC, F.U, F.GT};
        if (PG(1)) { const DenseOrder S{64, 32, 64 * 32, F.G, F.wg, F.XN, F.WIN}; pg::gemm_phase<EpiInproj, DenseOrder, NoHookPg, true, false>(ring, 1024, 1024, nullptr, S, E, NHP); }
        else dense_gemm_phase(F, F.XN, 1024, F.WIN, 1024, 64, 32, E, NH_); } SEAM(1);
    if (IN(2)) { p2_pool(F); p2_ssd_naive(F); } SEAM(2);
    if (IN(3)) { p3_rstd(F); const EpiPool E{F.YPG, F.GT};
        if (PG(3)) { __syncthreads(); const PoolOrder S{F.G, F.wg, F.PO, F.WPOOL}; pg::gemm_phase<EpiPool, PoolOrder, NoHookPg, false, false>(ring, 1024, 256, nullptr, S, E, NHP); }
        else {
#pragma unroll 1
        for (int ui = F.wg; ui < 64 * 4; ui += F.G) { GUnit u; u.pm = ui >> 2; u.pn = 0; u.e = ui & 3; u.a = F.PO + 256 * u.e; u.bt = F.WPOOL + (size_t)u.e * 65536; sgemm_unit(u, 1024, 256, nullptr, E, NH_, F.wave, F.lane); } } } SEAM(3);
    if (IN(4)) { const EpiOut E{F.MIXED, F.GT, F.YPG};
        if (PG(4)) { const DenseOrder S{64, 4, 256, F.G, F.wg, F.V, F.WOUT}; GUnit u0; LAS float* tab = (LAS float*)(F.lds + 131072 + 1024);
            if (S.next(0, u0) && F.tid < 256) { const f32x4 r = *(const f32x4*)(F.RSTD + (size_t)(u0.pm * 256 + F.tid) * 4); *(LAS f32x4*)(tab + F.tid * 4) = r; }
            __syncthreads();
            const RatioHook H{tab}; pg::gemm_phase<EpiOut, DenseOrder, RatioHook, false, false>(ring, 2048, 2048, nullptr, S, E, H); }
        else { const RstdHook H{F.RSTD}; dense_gemm_phase(F, F.V, 2048, F.WOUT, 2048, 64, 4, E, H); } } SEAM(4);
    if (IN(5)) { const EpiMix E{F.x, F.out};
        if (PG(5)) { const DenseOrder S{64, 4, 256, F.G, F.wg, F.MIXED, F.WMIX}; pg::gemm_phase<EpiMix, DenseOrder, NoHookPg, false, false>(ring, 1024, 1024, nullptr, S, E, NHP); }
        else dense_gemm_phase(F, F.MIXED, 1024, F.WMIX, 1024, 64, 4, E, NH_); } SEAM(5);
    if (IN(6)) { p6_router(F); } SEAM(6);
    if (IN(7)) { p7_route(F); } SEAM(7);
    if (IN(8)) { if (PG(8)) { const EpiGU E{F.ACT, F.b_gate_up}; const MoeOrder<8, 2048> S{F.G, F.wg, F.PSTART[32] / 256, F.TILE_E, F.XN, F.WGU};
            pg::gemm_phase<EpiGU, MoeOrder<8, 2048>, NoHookPg, true, true>(ring, 1024, 1024, F.ROWTOK, S, E, NHP); }
        else p8_moe_gu(F); } SEAM(8);
    if (IN(9)) { if (PG(9)) { const EpiDN E{F.YR, F.b_down}; const MoeOrder<4, 1024> S{F.G, F.wg, F.PSTART[32] / 256, F.TILE_E, F.ACT, F.WDN};
            pg::gemm_phase<EpiDN, MoeOrder<4, 1024>, NoHookPg, true, false>(ring, 1024, 1024, nullptr, S, E, NHP); }
        else p9_moe_dn(F); } SEAM(9);
    if (IN(10)) { p10_combine(F); } SEAM(10);
    if (IN(11)) { const EpiF32 E1{F.TMP}; const EpiPle E2{F.TMP, F.out};
        if (PG(11)) { const DenseOrder S1{64, 4, 256, F.G, F.wg, F.PB, F.WPP}; pg::gemm_phase<EpiF32, DenseOrder, NoHookPg, false, false>(ring, 256, 256, nullptr, S1, E1, NHP);
            asm volatile("s_waitcnt vmcnt(0)" ::: "memory"); __syncthreads();
            const DenseOrder S2{64, 4, 256, F.G, F.wg, F.XN, F.WPG}; pg::gemm_phase<EpiPle, DenseOrder, NoHookPg, false, false>(ring, 1024, 1024, nullptr, S2, E2, NHP); }
        else {
#pragma unroll 1
        for (int ui = F.wg; ui < 64 * 4; ui += F.G) { GUnit u; u.pm = ui >> 2; u.pn = ui & 3; u.e = 0; u.a = F.PB; u.bt = F.WPP; sgemm_unit(u, 256, 256, nullptr, E1, NH_, F.wave, F.lane);
            asm volatile("s_waitcnt vmcnt(0)" ::: "memory"); __syncthreads();
            u.a = F.XN; u.bt = F.WPG; sgemm_unit(u, 1024, 1024, nullptr, E2, NH_, F.wave, F.lane); } } } SEAM(11);
    if (IN(12)) { p12_final(F); }
#undef PG
#undef IN
#undef SEAM
}
}

extern "C" void kernel_launch(void* const* d_in, const int* in_sizes, int n_in, void* d_out, int out_size, void* d_ws, size_t ws_size, hipStream_t stream) {
    static int grid = 0;
    if (grid == 0) {
        if (n_in != 25 || in_sizes[0] != T * D || out_size != T * D || ws_size < WS_END) { fprintf(stderr, "kernel_launch: unexpected shapes (n_in %d, out %d, ws %zu)\n", n_in, out_size, ws_size); grid = -1; return; }
        int dev = 0, cus = 0, per_cu = 0;
        if (hipGetDevice(&dev) != hipSuccess || hipDeviceGetAttribute(&cus, hipDeviceAttributeMultiprocessorCount, dev) != hipSuccess) { grid = -1; return; }
        if (hipFuncSetAttribute((const void*)mk_fwd, hipFuncAttributeMaxDynamicSharedMemorySize, LDS_BYTES) != hipSuccess) { fprintf(stderr, "kernel_launch: hipFuncSetAttribute failed\n"); grid = -1; return; }
        if (hipOccupancyMaxActiveBlocksPerMultiprocessor(&per_cu, (const void*)mk_fwd, NTHREADS, LDS_BYTES) != hipSuccess || per_cu < 1) { fprintf(stderr, "kernel_launch: occupancy query says %d blocks/CU\n", per_cu); (void)hipGetLastError(); grid = -1; return; }
        grid = cus;
        if (grid != 256) { fprintf(stderr, "kernel_launch: built for a 256-CU device, found %d CUs\n", cus); grid = -1; return; }
    }
    if (grid < 0) return;
    (void)hipMemsetAsync((char*)d_ws + WS_CTL, 0, CTL_ZERO_BYTES, stream);
    Args a; memset(&a, 0, sizeof(a));
    for (int i = 0; i < 25; ++i) a.in[i] = (const float*)d_in[i];
    a.out = (float*)d_out; a.ws = (unsigned char*)d_ws;
#if MK_MULTI
    for (int ph = 0; ph < NPH; ++ph) { a.ph_lo = ph; a.ph_hi = ph + 1; hipLaunchKernelGGL(mk_fwd, dim3(grid), dim3(NTHREADS), LDS_BYTES, stream, a); }
#else
    a.ph_lo = 0; a.ph_hi = NPH;
    void* kargs[] = {&a};
    hipError_t e = hipLaunchCooperativeKernel((const void*)mk_fwd, dim3(grid), dim3(NTHREADS), kargs, LDS_BYTES, stream);
    if (e != hipSuccess) fprintf(stderr, "kernel_launch: cooperative launch failed: %s\n", hipGetErrorString(e));
#endif
}
```

```cpp
#include <hip/hip_runtime.h>
#include <cstdio>
#include <cstdint>
#include <cstring>

#ifndef PGMASK
#define PGMASK 0x1672
#endif
#ifndef SSD_FAST
#define SSD_FAST 1
#endif
#ifndef MK_MULTI
#define MK_MULTI 0
#endif

#define LAS __attribute__((address_space(3)))
#define GAS __attribute__((address_space(1)))
typedef unsigned short bf16;
typedef short bf16x8 __attribute__((ext_vector_type(8)));
typedef float f32x4 __attribute__((ext_vector_type(4)));
typedef unsigned u32x4 __attribute__((ext_vector_type(4)));
typedef unsigned u32x2 __attribute__((ext_vector_type(2)));

namespace {
constexpr int T = 16384, SEQ = 2048, NB = 8, D = 1024;
constexpr int DIN = 2048, NH = 32, DCONV = 3072, NPROJ = 8224;
constexpr int NE = 32, DE = 1024, DPLE = 256;
constexpr int NA = T * 4;
constexpr int MAXROWS = NA + NE * 256;
constexpr float EPS = 1e-6f;
constexpr int NWAVES = 8, NTHREADS = 512;
constexpr int NPH = 14;
constexpr size_t MiB = 1u << 20;
constexpr size_t WS_CTL = 0, CTL_ZERO_BYTES = 1 * MiB;
constexpr size_t WS_WIN = 2 * MiB, WS_WOUT = 18 * MiB, WS_WPOOL = 22 * MiB, WS_WMIX = 23 * MiB, WS_WPG = 25 * MiB, WS_WPP = 27 * MiB;
constexpr size_t WS_WGU = 28 * MiB, WS_WDN = 156 * MiB;
constexpr size_t WS_XN = 220 * MiB, WS_DT = 252 * MiB, WS_SS = 254 * MiB, WS_RSTD = 256 * MiB, WS_PO = 257 * MiB, WS_YPG = 289 * MiB, WS_MIXED = 321 * MiB, WS_PB = 353 * MiB;
constexpr size_t WS_ROUTE = 361 * MiB;
constexpr size_t WS_Z = 364 * MiB, WS_XBC = 428 * MiB, WS_U = 524 * MiB, WS_GT = 556 * MiB, WS_V = 620 * MiB;
constexpr size_t WS_ACT = 364 * MiB, WS_YR = 508 * MiB;
constexpr size_t WS_TMP = 684 * MiB;
constexpr size_t WS_BN = 684 * MiB, WS_CN = 700 * MiB, WS_BT = 716 * MiB;
constexpr size_t WS_END = 748 * MiB;
constexpr int CW_BAR = 4096;

__device__ __forceinline__ float bf2f(unsigned v) { return __uint_as_float(v << 16); }
__device__ __forceinline__ unsigned f2bf(float f) { unsigned u = __float_as_uint(f); return (u + 0x7fffu + ((u >> 16) & 1u)) >> 16; }
__device__ __forceinline__ unsigned pk2(float lo, float hi) { unsigned r; asm volatile("v_cvt_pk_bf16_f32 %0, %1, %2" : "=v"(r) : "v"(lo), "v"(hi)); return r; }
__device__ __forceinline__ float wave_sum(float v) {
#pragma unroll
    for (int o = 1; o < 64; o <<= 1) v += __shfl_xor(v, o);
    return v;
}
__device__ __forceinline__ float sigmoidf_(float x) { return 1.f / (1.f + __expf(-x)); }
__device__ __forceinline__ float siluf_(float x) { return x / (1.f + __expf(-x)); }
__device__ __forceinline__ void unpack8(const u32x4 w, float (&f)[8]) {
    f[0] = bf2f(w.x & 0xffffu); f[1] = bf2f(w.x >> 16); f[2] = bf2f(w.y & 0xffffu); f[3] = bf2f(w.y >> 16);
    f[4] = bf2f(w.z & 0xffffu); f[5] = bf2f(w.z >> 16); f[6] = bf2f(w.w & 0xffffu); f[7] = bf2f(w.w >> 16);
}
__device__ __forceinline__ u32x4 pack8(const f32x4 lo, const f32x4 hi) { u32x4 w; w.x = pk2(lo[0], lo[1]); w.y = pk2(lo[2], lo[3]); w.z = pk2(hi[0], hi[1]); w.w = pk2(hi[2], hi[3]); return w; }
__host__ __device__ __forceinline__ int perm32(int rho) { const int n = rho >> 4, i = rho & 15; return 8 * (i >> 2) + 4 * n + (i & 3); }

#define XB_TMO      128
#define XB_XCNT(j)  (256  + 64 * (j))
#define XB_XSUB(j)  (1280 + 64 * (j))
#define XB_XGEN(j)  (2304 + 64 * (j))
#define XB_TOP      3328
#define XB_TOPGEN   3392
#define XCD_BAR_WORDS 3456
#define XB_SPIN_CAP (1u << 18)
__device__ __forceinline__ unsigned xb_ld(unsigned* p)              { return __hip_atomic_load(p, __ATOMIC_RELAXED, __HIP_MEMORY_SCOPE_AGENT); }
__device__ __forceinline__ unsigned xb_add(unsigned* p, unsigned v) { return __hip_atomic_fetch_add(p, v, __ATOMIC_RELAXED, __HIP_MEMORY_SCOPE_AGENT); }
__device__ __forceinline__ unsigned xb_xcc_id() { return (unsigned)__builtin_amdgcn_s_getreg((3 << 11) | 20) & 0xFu; }
#define XB_SPIN(cond, bar) do { unsigned _sp = 0; while (cond) { __builtin_amdgcn_s_sleep(1); \
    if ((++_sp & 255u) == 0u) { if (xb_ld(&(bar)[XB_TMO])) break; if (_sp > XB_SPIN_CAP) { atomicAdd(&(bar)[XB_TMO], 1u); break; } } } } while (0)
struct XcdBarrier { unsigned* bar; unsigned x; volatile LAS unsigned* st; };
__device__ __forceinline__ XcdBarrier xcd_barrier_post(unsigned* bar, volatile LAS unsigned* st) {
    XcdBarrier b; b.bar = bar; b.x = xb_xcc_id(); b.st = st;
    if (threadIdx.x == 0) (void)xb_add(&bar[XB_XCNT(b.x)], 1u);
    return b;
}
__device__ __forceinline__ void xcd_barrier_complete(unsigned* bar, unsigned x, unsigned& nloc, unsigned& nx) {
    const unsigned G = gridDim.x * gridDim.y * gridDim.z;
    unsigned sum, cnt, mine, sp = 0u;
    for (;;) {
        sum = 0u; cnt = 0u; mine = 0u;
#pragma unroll
        for (unsigned j = 0; j < 16; ++j) { const unsigned c = xb_ld(&bar[XB_XCNT(j)]); sum += c; cnt += (c > 0u) ? 1u : 0u; mine = (j == x) ? c : mine; }
        if (sum == G) break;
        __builtin_amdgcn_s_sleep(1);
        if ((++sp & 255u) == 0u) { if (xb_ld(&bar[XB_TMO])) break; if (sp > XB_SPIN_CAP) { atomicAdd(&bar[XB_TMO], 1u); break; } }
    }
    nloc = mine > 0u ? mine : 1u; nx = cnt > 0u ? cnt : 1u;
}
__device__ __forceinline__ void xcd_barrier(const XcdBarrier& b) {
    asm volatile("s_waitcnt vmcnt(0)" ::: "memory");
    __syncthreads();
    if (threadIdx.x == 0) {
        unsigned* bar = b.bar;
        __builtin_amdgcn_s_waitcnt(0);
        unsigned nloc = b.st[0], nx = b.st[1];
        if (nloc == 0u) { xcd_barrier_complete(bar, b.x, nloc, nx); b.st[0] = nloc; b.st[1] = nx; }
        const unsigned old = xb_add(&bar[XB_XSUB(b.x)], 1u);
        const unsigned gen = old / nloc;
        if (old + 1u == (gen + 1u) * nloc) {
            __builtin_amdgcn_fence(__ATOMIC_RELEASE, "agent");
            asm volatile("s_waitcnt vmcnt(0)" ::: "memory");
            const unsigned og = xb_add(&bar[XB_TOP], 1u);
            const unsigned tg = og / nx;
            if (og + 1u == (tg + 1u) * nx) xb_add(&bar[XB_TOPGEN], 1u);
            else XB_SPIN(xb_ld(&bar[XB_TOPGEN]) == tg, bar);
            __builtin_amdgcn_fence(__ATOMIC_ACQUIRE, "agent");
            xb_add(&bar[XB_XGEN(b.x)], 1u);
            asm volatile("s_waitcnt vmcnt(0)" ::: "memory");
        } else {
            XB_SPIN(xb_ld(&bar[XB_XGEN(b.x)]) == gen, bar);
            __builtin_amdgcn_fence(__ATOMIC_ACQUIRE, "agent");
            asm volatile("s_waitcnt vmcnt(0)" ::: "memory");
        }
    }
    __syncthreads();
}

struct Args { const float* in[25]; float* out; unsigned char* ws; int ph_lo, ph_hi; };
struct Frame {
    LAS unsigned char* lds; int tid, lane, wave, G, wg;
    const float *x, *p, *mix_norm_g, *w_in, *conv_w, *conv_b, *dt_bias, *a_log, *d_skip, *ssd_norm_g, *w_ssd_out, *pool_w, *pool_scale, *w_mix_out, *ffn_norm_g, *w_router, *b_router,
        *w_gate_up, *b_gate_up, *w_down, *b_down, *ple_norm_g, *w_ple_gate, *w_ple_proj, *final_norm_g;
    float* out;
    bf16 *WIN, *WOUT, *WPOOL, *WMIX, *WPG, *WPP, *WGU, *WDN;
    bf16 *XN, *PO, *YPG, *MIXED, *PB, *Z, *XBC, *U, *GT, *V, *ACT, *YR;
    float *DT, *SS, *RSTD, *TMP;
    bf16 *BN, *CN, *BT;
    int *TIDX, *DEST, *ROWTOK, *CNT, *PSTART, *TILE_E; float* TW;
};

struct GUnit { int pm, pn, e; const bf16* a; const bf16* bt; };
struct NoHook { static constexpr bool ON = false; __device__ __forceinline__ float ratio(int, int) const { return 1.f; } };
struct RstdHook { static constexpr bool ON = true; const float* rstd;
    __device__ __forceinline__ float ratio(int row, int g) const { return rstd[row * 4 + g]; } };

template <class Epi, class Hook>
__device__ __forceinline__ void sgemm_unit(const GUnit& u, int lda, int K, const int* gather, const Epi& E, const Hook& H, int wave, int lane) {
    const int wr = wave >> 2, wc = wave & 3, fr = lane & 15, fq = lane >> 4;
#pragma unroll 1
    for (int ai = 0; ai < 2; ++ai) {
        f32x4 acc[2][4][2];
#pragma unroll
        for (int bj = 0; bj < 2; ++bj)
#pragma unroll
            for (int m = 0; m < 4; ++m)
#pragma unroll
                for (int n = 0; n < 2; ++n) acc[bj][m][n] = (f32x4){0.f, 0.f, 0.f, 0.f};
        const bf16* ap[4]; const bf16* bp[2][2];
#pragma unroll
        for (int m = 0; m < 4; ++m) { const int row = u.pm * 256 + ai * 128 + wr * 64 + m * 16 + fr; const int src = gather ? gather[row] : row; ap[m] = u.a + (size_t)src * lda + 8 * fq; }
#pragma unroll
        for (int bj = 0; bj < 2; ++bj)
#pragma unroll
            for (int n = 0; n < 2; ++n) bp[bj][n] = u.bt + (size_t)(u.pn * 256 + bj * 128 + wc * 32 + perm32(n * 16 + fr)) * K + 8 * fq;
#pragma unroll 1
        for (int k0 = 0; k0 < K; k0 += 32) {
            bf16x8 af[4], bf[2][2];
#pragma unroll
            for (int m = 0; m < 4; ++m) af[m] = *(const bf16x8*)(ap[m] + k0);
#pragma unroll
            for (int bj = 0; bj < 2; ++bj)
#pragma unroll
                for (int n = 0; n < 2; ++n) bf[bj][n] = *(const bf16x8*)(bp[bj][n] + k0);
#pragma unroll
            for (int bj = 0; bj < 2; ++bj)
#pragma unroll
                for (int m = 0; m < 4; ++m)
#pragma unroll
                    for (int n = 0; n < 2; ++n) acc[bj][m][n] = __builtin_amdgcn_mfma_f32_16x16x32_bf16(bf[bj][n], af[m], acc[bj][m][n], 0, 0, 0);
            if (Hook::ON && ((k0 + 32) & 511) == 0) {
                const int g = (k0 + 32) / 512 - 1;
#pragma unroll
                for (int m = 0; m < 4; ++m) { const float r = H.ratio(u.pm * 256 + ai * 128 + wr * 64 + m * 16 + fr, g);
#pragma unroll
                    for (int bj = 0; bj < 2; ++bj)
#pragma unroll
                        for (int n = 0; n < 2; ++n) acc[bj][m][n] *= r; }
            }
        }
#pragma unroll
        for (int m = 0; m < 4; ++m) {
            const int row = u.pm * 256 + ai * 128 + wr * 64 + m * 16 + fr, colh = wc * 32 + 8 * fq;
            if constexpr (Epi::PAIR) E.pair(u, row, colh, acc[0][m][0], acc[0][m][1], acc[1][m][0], acc[1][m][1]);
            else { E(u, row, u.pn * 256 + colh, acc[0][m][0], acc[0][m][1]); E(u, row, u.pn * 256 + 128 + colh, acc[1][m][0], acc[1][m][1]); }
        }
    }
}


namespace pg {
constexpr int BK = 64, HALF = 128, HTB = HALF * BK * 2;
__host__ __device__ __forceinline__ int lds_byte(int r, int c) { const int st = (r >> 4) * 2 + (c >> 5), rr = r & 15, cc = c & 31, ob = rr * 64 + cc * 2; return st * 1024 + (ob ^ (((ob >> 9) & 1) << 5)); }
__host__ __device__ __forceinline__ void stage_rc(int b, int& R, int& C) { const int st = b / 1024, sb = b % 1024, swz = sb ^ (((sb >> 9) & 1) << 5); R = (st >> 1) * 16 + swz / 64; C = (st & 1) * 32 + (swz % 64) / 2; }

template <class Epi>
__device__ __forceinline__ void run_epi(const Epi& E, const f32x4 (&acc)[2][2][4][2], const GUnit& u, int wr, int wc, int fr, int fq) {
#pragma unroll
    for (int ai = 0; ai < 2; ++ai)
#pragma unroll
        for (int m = 0; m < 4; ++m) {
            const int row = u.pm * 256 + ai * 128 + wr * 64 + m * 16 + fr, colh = wc * 32 + 8 * fq;
            if constexpr (Epi::PAIR) E.pair(u, row, colh, acc[ai][0][m][0], acc[ai][0][m][1], acc[ai][1][m][0], acc[ai][1][m][1]);
            else { E(u, row, u.pn * 256 + colh, acc[ai][0][m][0], acc[ai][0][m][1]); E(u, row, u.pn * 256 + 128 + colh, acc[ai][1][m][0], acc[ai][1][m][1]); }
        }
}

template <class Epi, class Sched, class Hook, bool ALIGN_EPI, bool GATHER>
__device__ __forceinline__ void gemm_phase(LAS unsigned char* lds, const int lda, const int K, const int* gather, const Sched& S, const Epi& E, const Hook& H) {
    const int tid = threadIdx.x, wid = __builtin_amdgcn_readfirstlane(tid >> 6), lane = tid & 63, wr = wid >> 2, wc = wid & 3, fr = lane & 15, fq = lane >> 4;
    const int nt = K / BK;
    unsigned voffA[2], voffB[2]; int R0, C0;
    { int R, C; stage_rc(tid * 16, R, C); R0 = R; C0 = C; }
#pragma unroll
    for (int i = 0; i < 2; ++i) { const int R = R0 + 64 * i; const int Rb = (R & ~31) + perm32(R & 31); voffA[i] = (unsigned)(R * lda + C0) * 2u; voffB[i] = (unsigned)(Rb * K + C0) * 2u; }
    const size_t kstep = (size_t)(BK * 2);
    const size_t hstepA = (size_t)HALF * lda * 2, hstepB = (size_t)HALF * K * 2;
    const unsigned ldsw = (unsigned)wid * 1024u;
    const int aoff = lds_byte(wr * 64 + fr, fq * 8), boff = lds_byte(wc * 32 + fr, fq * 8);
#define PG_SA(b, h) (((b) * 2 + (h)) * HTB)
#define PG_SB(b, h) ((4 + (b) * 2 + (h)) * HTB)
#define PG_GLDS(gp, bufoff, i) __builtin_amdgcn_global_load_lds((const unsigned*)(gp), (LAS unsigned*)(lds + (bufoff) + ldsw + (i) * 8192), 16, 0, 0)
#define PG_STAGE_B(bufoff, gbase) do { _Pragma("unroll") for (int _i = 0; _i < 2; ++_i) PG_GLDS((const char*)(gbase) + voffB[_i], bufoff, _i); } while (0)
#define PG_STAGE_A(bufoff, kp, h, NX) do { _Pragma("unroll") for (int _i = 0; _i < 2; ++_i) { \
        const char* _g = GATHER ? (const char*)(kp) + ((NX) ? nOff[h][_i] : cOff[h][_i]) : (const char*)(kp) + (size_t)(h) * hstepA + voffA[_i]; PG_GLDS(_g, bufoff, _i); } } while (0)
#define PG_LDA(dst, b, h) do { _Pragma("unroll") for (int m = 0; m < 4; ++m) _Pragma("unroll") for (int k = 0; k < 2; ++k) dst[m][k] = *(const LAS bf16x8*)(lds + PG_SA(b, h) + aoff + m * 2048 + k * 1024); } while (0)
#define PG_LDB(dst, b, h) do { _Pragma("unroll") for (int n = 0; n < 2; ++n) _Pragma("unroll") for (int k = 0; k < 2; ++k) dst[n][k] = *(const LAS bf16x8*)(lds + PG_SB(b, h) + boff + n * 2048 + k * 1024); } while (0)
#define PG_MMA(ai, bj, At, Bt) do { __builtin_amdgcn_s_setprio(1); _Pragma("unroll") for (int m = 0; m < 4; ++m) _Pragma("unroll") for (int n = 0; n < 2; ++n) _Pragma("unroll") for (int k = 0; k < 2; ++k) \
        acc[ai][bj][m][n] = __builtin_amdgcn_mfma_f32_16x16x32_bf16(Bt[n][k], At[m][k], acc[ai][bj][m][n], 0, 0, 0); __builtin_amdgcn_s_setprio(0); } while (0)
#define PG_WAIT_V(n) asm volatile("s_waitcnt vmcnt(" #n ")" ::: "memory")
#define PG_WAIT_L(n) asm volatile("s_waitcnt lgkmcnt(" #n ")" ::: "memory")
#define PG_BAR __builtin_amdgcn_s_barrier()
#define PG_SCHED __builtin_amdgcn_sched_barrier(0)
    GUnit cur, nxt; int ui = 0;
    if (!S.next(0, cur)) return;
    unsigned cOff[2][2] = {{0u, 0u}, {0u, 0u}}, nOff[2][2] = {{0u, 0u}, {0u, 0u}};
    if constexpr (GATHER) {
#pragma unroll
        for (int h = 0; h < 2; ++h)
#pragma unroll
            for (int i = 0; i < 2; ++i) cOff[h][i] = (unsigned)(gather[cur.pm * 256 + h * 128 + R0 + 64 * i] * lda + C0) * 2u;
    }
    f32x4 acc[2][2][4][2];
#pragma unroll
    for (int a = 0; a < 2; ++a)
#pragma unroll
        for (int b = 0; b < 2; ++b)
#pragma unroll
            for (int m = 0; m < 4; ++m)
#pragma unroll
                for (int n = 0; n < 2; ++n) acc[a][b][m][n] = (f32x4){0.f, 0.f, 0.f, 0.f};
    bf16x8 At[4][2], B0[2][2], B1[2][2];
    const char* cA = (const char*)cur.a + (GATHER ? (size_t)0 : (size_t)cur.pm * 2 * hstepA); const char* cB = (const char*)cur.bt + (size_t)cur.pn * 2 * hstepB;
    PG_STAGE_B(PG_SB(0, 0), cB); PG_STAGE_B(PG_SB(0, 1), cB + hstepB); PG_STAGE_A(PG_SA(0, 0), cA, 0, false); PG_STAGE_A(PG_SA(0, 1), cA, 1, false);
    if (wr == 1) PG_BAR;
    PG_WAIT_V(2); PG_BAR;
    PG_STAGE_B(PG_SB(1, 0), cB + kstep); PG_STAGE_A(PG_SA(1, 0), cA + kstep, 0, false); PG_STAGE_B(PG_SB(1, 1), cB + hstepB + kstep);
    PG_WAIT_V(6); PG_BAR;
    for (;;) {
        const bool has_next = S.next(ui + 1, nxt);
        const char* nA = has_next ? (const char*)nxt.a + (GATHER ? (size_t)0 : (size_t)nxt.pm * 2 * hstepA) : cA; const char* nB = has_next ? (const char*)nxt.bt + (size_t)nxt.pn * 2 * hstepB : cB;
        if constexpr (GATHER) {
            if (has_next) {
#pragma unroll
                for (int h = 0; h < 2; ++h)
#pragma unroll
                    for (int i = 0; i < 2; ++i) nOff[h][i] = (unsigned)(gather[nxt.pm * 256 + h * 128 + R0 + 64 * i] * lda + C0) * 2u;
            } else {
#pragma unroll
                for (int h = 0; h < 2; ++h)
#pragma unroll
                    for (int i = 0; i < 2; ++i) nOff[h][i] = cOff[h][i];
            }
        }
        for (int t = 0; t < nt; t += 2) {
            const bool last = (t == nt - 2);
            const char* a1 = cA + (size_t)(t + 1) * kstep;
            const char* a2 = last ? nA : cA + (size_t)(t + 2) * kstep; const char* b2 = last ? nB : cB + (size_t)(t + 2) * kstep;
            const char* a3 = a2 + kstep; const char* b3 = b2 + kstep;
            PG_LDB(B0, 0, 0); PG_LDB(B1, 0, 1); PG_SCHED; PG_LDA(At, 0, 0); PG_STAGE_A(PG_SA(1, 1), a1, 1, false);
            PG_WAIT_V(8); PG_WAIT_L(0); PG_BAR; PG_MMA(0, 0, At, B0); PG_MMA(0, 1, At, B1); PG_BAR; PG_SCHED;
            PG_LDA(At, 0, 1); PG_STAGE_B(PG_SB(0, 0), b2); PG_STAGE_B(PG_SB(0, 1), b2 + hstepB); PG_STAGE_A(PG_SA(0, 0), a2, 0, last);
            PG_WAIT_V(8); PG_WAIT_L(0); PG_BAR; PG_MMA(1, 0, At, B0); PG_MMA(1, 1, At, B1); PG_BAR; PG_SCHED;
            PG_LDB(B0, 1, 0); PG_LDB(B1, 1, 1); PG_SCHED; PG_LDA(At, 1, 0); PG_STAGE_A(PG_SA(0, 1), a2, 1, last);
            PG_WAIT_V(8); PG_WAIT_L(0); PG_BAR; PG_MMA(0, 0, At, B0); PG_MMA(0, 1, At, B1); PG_BAR; PG_SCHED;
            PG_LDA(At, 1, 1); PG_STAGE_B(PG_SB(1, 0), b3); PG_STAGE_B(PG_SB(1, 1), b3 + hstepB); PG_STAGE_A(PG_SA(1, 0), a3, 0, last);
            PG_WAIT_V(8); PG_WAIT_L(0); PG_BAR; PG_MMA(1, 0, At, B0); PG_MMA(1, 1, At, B1); PG_BAR; PG_SCHED;
            if constexpr (Hook::ON) { if (((t + 2) & 7) == 0) H.apply(acc, (t + 2) / 8 - 1, wr, fr); }
        }
        if constexpr (ALIGN_EPI) { if (wr == 0) PG_BAR; }
        run_epi(E, acc, cur, wr, wc, fr, fq);
        if (!has_next) break;
#pragma unroll
        for (int a = 0; a < 2; ++a)
#pragma unroll
            for (int b = 0; b < 2; ++b)
#pragma unroll
                for (int m = 0; m < 4; ++m)
#pragma unroll
                    for (int n = 0; n < 2; ++n) acc[a][b][m][n] = (f32x4){0.f, 0.f, 0.f, 0.f};
        cur = nxt; cA = nA; cB = nB; ++ui;
        if constexpr (GATHER) {
#pragma unroll
            for (int h = 0; h < 2; ++h)
#pragma unroll
                for (int i = 0; i < 2; ++i) cOff[h][i] = nOff[h][i];
        }
        if constexpr (ALIGN_EPI) { if (wr == 1) PG_BAR; }
    }
    PG_WAIT_V(0);
    if constexpr (!ALIGN_EPI) { if (wr == 0) PG_BAR; }
    PG_BAR;
#undef PG_SA
#undef PG_SB
#undef PG_GLDS
#undef PG_STAGE_A
#undef PG_STAGE_B
#undef PG_LDA
#undef PG_LDB
#undef PG_MMA
#undef PG_WAIT_V
#undef PG_WAIT_L
#undef PG_BAR
#undef PG_SCHED
}
}

struct DenseOrder {
    int nM, nN, nwg, G, c; const bf16* a; const bf16* bt;
    __device__ __forceinline__ bool next(int i, GUnit& u) const {
        const int L = i * G + c; if (L >= nwg) return false;
        int wgid = L; { const int q = nwg / 8, r = nwg % 8, xcd = wgid % 8, off = wgid / 8; wgid = (xcd < r ? xcd * (q + 1) : r * (q + 1) + (xcd - r) * q) + off; }
        const int nig = 8 * nN, gid = wgid / nig, fm = gid * 8, gsz = (nM - fm) < 8 ? (nM - fm) : 8;
        u.pm = fm + ((wgid % nig) % gsz); u.pn = (wgid % nig) / gsz; u.e = 0; u.a = a; u.bt = bt; return true;
    } };
struct PoolOrder { int G, c; const bf16* PO; const bf16* WPOOL;
    __device__ __forceinline__ bool next(int i, GUnit& u) const { const int L = i * G + c; if (L >= 256) return false; u.pm = L >> 2; u.pn = 0; u.e = L & 3; u.a = PO + 256 * u.e; u.bt = WPOOL + (size_t)u.e * 65536; return true; } };
template <int NCOL, int BROWS> struct MoeOrder { int G, c, nrt; const int* tile_e; const bf16* a; const bf16* w;
    __device__ __forceinline__ bool next(int i, GUnit& u) const { const int L = i * G + c; if (L >= nrt * NCOL) return false; u.pm = L / NCOL; u.pn = L % NCOL; u.e = tile_e[u.pm]; u.a = a; u.bt = w + (size_t)u.e * BROWS * 1024; return true; } };
struct NoHookPg { static constexpr bool ON = false; __device__ __forceinline__ void apply(f32x4 (&)[2][2][4][2], int, int, int) const {} };
struct RatioHook { static constexpr bool ON = true; const LAS float* tab;
    __device__ __forceinline__ void apply(f32x4 (&acc)[2][2][4][2], int g, int wr, int fr) const {
#pragma unroll
        for (int ai = 0; ai < 2; ++ai)
#pragma unroll
            for (int m = 0; m < 4; ++m) { const float r = tab[(ai * 128 + wr * 64 + m * 16 + fr) * 4 + g];
#pragma unroll
                for (int bj = 0; bj < 2; ++bj)
#pragma unroll
                    for (int n = 0; n < 2; ++n) acc[ai][bj][m][n] *= r; }
    } };

struct EpiInproj { static constexpr bool PAIR = false; bf16 *Z, *XBC, *U, *GT;
    __device__ __forceinline__ void operator()(const GUnit&, int row, int col, f32x4 lo, f32x4 hi) const {
        if (col < 2048) { for (int i = 0; i < 4; ++i) { lo[i] = siluf_(lo[i]); hi[i] = siluf_(hi[i]); } *(u32x4*)(Z + (size_t)row * 2048 + col) = pack8(lo, hi); }
        else if (col < 5120) *(u32x4*)(XBC + (size_t)row * 3072 + (col - 2048)) = pack8(lo, hi);
        else if (col < 6144) *(u32x4*)(U + (size_t)row * 1024 + (col - 5120)) = pack8(lo, hi);
        else { for (int i = 0; i < 4; ++i) { lo[i] = sigmoidf_(lo[i]); hi[i] = sigmoidf_(hi[i]); } *(u32x4*)(GT + (size_t)row * 2048 + (col - 6144)) = pack8(lo, hi); }
    } };
struct EpiPool { static constexpr bool PAIR = false; bf16* YPG; const bf16* GT;
    __device__ __forceinline__ void operator()(const GUnit& u, int row, int col, f32x4 lo, f32x4 hi) const {
        const int c = u.e * 256 + col; float g[8]; unpack8(*(const u32x4*)(GT + (size_t)row * 2048 + 1024 + c), g);
        for (int i = 0; i < 4; ++i) { lo[i] *= g[i]; hi[i] *= g[4 + i]; }
        *(u32x4*)(YPG + (size_t)row * 1024 + c) = pack8(lo, hi);
    } };
struct EpiOut { static constexpr bool PAIR = false; bf16* MIXED; const bf16 *GT, *YPG;
    __device__ __forceinline__ void operator()(const GUnit&, int row, int col, f32x4 lo, f32x4 hi) const {
        float g[8], y[8]; unpack8(*(const u32x4*)(GT + (size_t)row * 2048 + col), g); unpack8(*(const u32x4*)(YPG + (size_t)row * 1024 + col), y);
        for (int i = 0; i < 4; ++i) { lo[i] = lo[i] * g[i] + y[i]; hi[i] = hi[i] * g[4 + i] + y[4 + i]; }
        *(u32x4*)(MIXED + (size_t)row * 1024 + col) = pack8(lo, hi);
    } };
struct EpiMix { static constexpr bool PAIR = false; const float* x; float* X1;
    __device__ __forceinline__ void operator()(const GUnit&, int row, int col, f32x4 lo, f32x4 hi) const {
        const f32x4 a = *(const f32x4*)(x + (size_t)row * 1024 + col), b = *(const f32x4*)(x + (size_t)row * 1024 + col + 4);
        *(f32x4*)(X1 + (size_t)row * 1024 + col) = a + lo; *(f32x4*)(X1 + (size_t)row * 1024 + col + 4) = b + hi;
    } };
struct EpiGU { static constexpr bool PAIR = true; bf16* ACT; const float* b_gate_up;
    __device__ __forceinline__ void pair(const GUnit& u, int row, int colh, f32x4 g0, f32x4 g1, f32x4 u0, f32x4 u1) const {
        const int c = u.pn * 128 + colh; const float* bg = b_gate_up + (size_t)u.e * 2048 + c;
        const f32x4 bg0 = *(const f32x4*)bg, bg1 = *(const f32x4*)(bg + 4), bu0 = *(const f32x4*)(bg + 1024), bu1 = *(const f32x4*)(bg + 1028);
        f32x4 lo, hi;
        for (int i = 0; i < 4; ++i) {
            float ga = fminf(g0[i] + bg0[i], 7.f), up = fminf(fmaxf(u0[i] + bu0[i], -7.f), 7.f); lo[i] = (up + 1.f) * ga * sigmoidf_(1.702f * ga);
            ga = fminf(g1[i] + bg1[i], 7.f); up = fminf(fmaxf(u1[i] + bu1[i], -7.f), 7.f); hi[i] = (up + 1.f) * ga * sigmoidf_(1.702f * ga); }
        *(u32x4*)(ACT + (size_t)row * 1024 + c) = pack8(lo, hi);
    } };
struct EpiDN { static constexpr bool PAIR = false; bf16* YR; const float* b_down;
    __device__ __forceinline__ void operator()(const GUnit& u, int row, int col, f32x4 lo, f32x4 hi) const {
        const float* b = b_down + (size_t)u.e * 1024 + col; lo += *(const f32x4*)b; hi += *(const f32x4*)(b + 4);
        *(u32x4*)(YR + (size_t)row * 1024 + col) = pack8(lo, hi);
    } };
struct EpiF32 { static constexpr bool PAIR = false; float* C;
    __device__ __forceinline__ void operator()(const GUnit&, int row, int col, f32x4 lo, f32x4 hi) const { *(f32x4*)(C + (size_t)row * 1024 + col) = lo; *(f32x4*)(C + (size_t)row * 1024 + col + 4) = hi; } };
struct EpiPle { static constexpr bool PAIR = false; const float* TMP; float* X;
    __device__ __forceinline__ void operator()(const GUnit&, int row, int col, f32x4 lo, f32x4 hi) const {
        float* xp = X + (size_t)row * 1024 + col; const float* tp = TMP + (size_t)row * 1024 + col;
        const f32x4 t0 = *(const f32x4*)tp, t1 = *(const f32x4*)(tp + 4); f32x4 x0 = *(const f32x4*)xp, x1 = *(const f32x4*)(xp + 4);
        for (int i = 0; i < 4; ++i) { x0[i] += sigmoidf_(lo[i]) * t0[i]; x1[i] += sigmoidf_(hi[i]) * t1[i]; }
        *(f32x4*)xp = x0; *(f32x4*)(xp + 4) = x1;
    } };

__device__ __forceinline__ void tr_item(const float* W, int ldw, int n0src, int k0, bf16* WT, int K, int dstrow0, const float* kscale, const float* nscale, LAS float* scr, int lane) {
    const int kk0 = lane >> 4, nn = 4 * (lane & 15);
    f32x4 v[16];
#pragma unroll
    for (int i = 0; i < 16; ++i) v[i] = *(const f32x4*)(W + (size_t)(k0 + 4 * i + kk0) * ldw + n0src + nn);
    if (nscale) { const f32x4 ns = *(const f32x4*)(nscale + n0src + nn);
#pragma unroll
        for (int i = 0; i < 16; ++i) v[i] *= ns; }
    if (kscale) {
#pragma unroll
        for (int i = 0; i < 16; ++i) v[i] *= kscale[k0 + 4 * i + kk0]; }
#pragma unroll
    for (int i = 0; i < 16; ++i) { LAS float* d = scr + (4 * i + kk0) * 65 + nn; d[0] = v[i][0]; d[1] = v[i][1]; d[2] = v[i][2]; d[3] = v[i][3]; }
    asm volatile("s_waitcnt lgkmcnt(0)" ::: "memory");
    const int c = lane & 7;
#pragma unroll
    for (int j = 0; j < 8; ++j) { const int n = (lane >> 3) + 8 * j; const LAS float* sp = scr + (8 * c) * 65 + n;
        u32x4 o; o.x = pk2(sp[0 * 65], sp[1 * 65]); o.y = pk2(sp[2 * 65], sp[3 * 65]); o.z = pk2(sp[4 * 65], sp[5 * 65]); o.w = pk2(sp[6 * 65], sp[7 * 65]);
        *(u32x4*)(WT + (size_t)(dstrow0 + n) * K + k0 + 8 * c) = o; }
    asm volatile("s_waitcnt lgkmcnt(0)" ::: "memory");
}
constexpr int O_W32 = 0, O_W32_SCR = 131072 + 8192, O_W32_CNT = 131072 + 4096;
__device__ __forceinline__ void w32_fill(const Frame& F, const float* src, int ld) {
#pragma unroll 4
    for (int i = 0; i < 16; ++i) { const int idx = F.tid + NTHREADS * i, k = idx >> 3, cq = idx & 7;
        *(LAS f32x4*)(F.lds + O_W32 + k * 128 + ((cq ^ ((k >> 1) & 7)) << 4)) = *(const f32x4*)(src + (size_t)k * ld + cq * 4); }
}
__device__ __forceinline__ float w32_dot(const LAS unsigned char* lds, const float (&xv)[16], int lane) {
    float lg[32];
#pragma unroll
    for (int e = 0; e < 32; ++e) lg[e] = 0.f;
    const int sw = (lane >> 1) & 7;
#pragma unroll
    for (int q = 0; q < 16; ++q) { const LAS unsigned char* rowp = lds + O_W32 + (lane + 64 * q) * 128;
#pragma unroll
        for (int cq = 0; cq < 8; ++cq) { const f32x4 w = *(const LAS f32x4*)(rowp + ((cq ^ sw) << 4));
            lg[4 * cq] = fmaf(xv[q], w[0], lg[4 * cq]); lg[4 * cq + 1] = fmaf(xv[q], w[1], lg[4 * cq + 1]); lg[4 * cq + 2] = fmaf(xv[q], w[2], lg[4 * cq + 2]); lg[4 * cq + 3] = fmaf(xv[q], w[3], lg[4 * cq + 3]); } }
#pragma unroll
    for (int half = 16, bit = 32; half >= 1; half >>= 1, bit >>= 1) {
        const bool up = (lane & bit) != 0;
#pragma unroll
        for (int i = 0; i < 16; ++i) if (i < half) { const float send = up ? lg[i] : lg[i + half], keep = up ? lg[i + half] : lg[i]; lg[i] = keep + __shfl_xor(send, bit); }
    }
    return lg[0] + __shfl_xor(lg[0], 1);
}
__device__ __forceinline__ int w32_col(int lane) { return ((lane >> 5) & 1) * 16 + ((lane >> 4) & 1) * 8 + ((lane >> 3) & 1) * 4 + ((lane >> 2) & 1) * 2 + ((lane >> 1) & 1); }

__device__ __forceinline__ void p0_prologue(const Frame& F) {
    LAS float* scr = (LAS float*)(F.lds + F.wave * 16640);
    const int gw = F.wg * NWAVES + F.wave, NGW = F.G * NWAVES, lane = F.lane;
    constexpr int I_WIN = 16 * 128, I_WOUT = 32 * 16, I_WPOOL = 4 * 4 * 4, I_WMIX = 16 * 16, I_WPG = 16 * 16, I_WPP = 4 * 16, I_WGU = 32 * 16 * 32, I_WDN = 32 * 16 * 16;
    constexpr int NITEMS = I_WIN + I_WOUT + I_WPOOL + I_WMIX + I_WPG + I_WPP + I_WGU + I_WDN;
#pragma unroll 1
    for (int it = gw; it < NITEMS; it += NGW) {
        int r = it;
        if (r < I_WIN) { const int kb = r >> 7, nb = r & 127; const int dst = 64 * nb, src = dst + (dst >= 5120 ? 32 : 0); tr_item(F.w_in, NPROJ, src, 64 * kb, F.WIN, 1024, dst, nullptr, nullptr, scr, lane); continue; } r -= I_WIN;
        if (r < I_WOUT) { const int kb = r >> 4, nb = r & 15; tr_item(F.w_ssd_out, 1024, 64 * nb, 64 * kb, F.WOUT, 2048, 64 * nb, F.ssd_norm_g, nullptr, scr, lane); continue; } r -= I_WOUT;
        if (r < I_WPOOL) { const int g = r >> 4, q = r & 15, kb = q >> 2, nb = q & 3; tr_item(F.pool_w + (size_t)g * 65536, 256, 64 * nb, 64 * kb, F.WPOOL + (size_t)g * 65536, 256, 64 * nb, nullptr, F.pool_scale + g * 256, scr, lane); continue; } r -= I_WPOOL;
        if (r < I_WMIX) { const int kb = r >> 4, nb = r & 15; tr_item(F.w_mix_out, 1024, 64 * nb, 64 * kb, F.WMIX, 1024, 64 * nb, nullptr, nullptr, scr, lane); continue; } r -= I_WMIX;
        if (r < I_WPG) { const int kb = r >> 4, nb = r & 15; tr_item(F.w_ple_gate, 1024, 64 * nb, 64 * kb, F.WPG, 1024, 64 * nb, nullptr, nullptr, scr, lane); continue; } r -= I_WPG;
        if (r < I_WPP) { const int kb = r >> 4, nb = r & 15; tr_item(F.w_ple_proj, 1024, 64 * nb, 64 * kb, F.WPP, 256, 64 * nb, nullptr, nullptr, scr, lane); continue; } r -= I_WPP;
        if (r < I_WGU) { const int e = r >> 9, q = r & 511, kb = q >> 5, nb = q & 31; const int c = 64 * nb, sx = c >> 10, rr = c & 1023, dst = 256 * (rr >> 7) + 128 * sx + (rr & 127);
            tr_item(F.w_gate_up + (size_t)e * 1024 * 2048, 2048, c, 64 * kb, F.WGU + (size_t)e * 2048 * 1024, 1024, dst, nullptr, nullptr, scr, lane); continue; } r -= I_WGU;
        { const int e = r >> 8, q = r & 255, kb = q >> 4, nb = q & 15; tr_item(F.w_down + (size_t)e * 1024 * 1024, 1024, 64 * nb, 64 * kb, F.WDN + (size_t)e * 1024 * 1024, 1024, 64 * nb, nullptr, nullptr, scr, lane); }
    }
    const size_t n8 = (size_t)T * DPLE / 8;
#pragma unroll 1
    for (size_t i = (size_t)F.wg * NTHREADS + F.tid; i < n8; i += (size_t)F.G * NTHREADS) { const f32x4 a = ((const f32x4*)F.p)[2 * i], b = ((const f32x4*)F.p)[2 * i + 1]; ((u32x4*)F.PB)[i] = pack8(a, b); }
    __syncthreads();
    w32_fill(F, F.w_in + 5120, NPROJ);
    float gq[16];
#pragma unroll
    for (int q = 0; q < 16; ++q) gq[q] = F.mix_norm_g[lane + 64 * q];
    __syncthreads();
#pragma unroll 1
    for (int rr = 0; rr < 8; ++rr) {
        const int row = F.wg * 64 + F.wave * 8 + rr;
        const f32x4* xr = (const f32x4*)(F.x + (size_t)row * D) + lane;
        f32x4 v[4]; float s = 0.f;
#pragma unroll
        for (int j = 0; j < 4; ++j) { v[j] = xr[64 * j]; s += (v[j][0] * v[j][0] + v[j][1] * v[j][1]) + (v[j][2] * v[j][2] + v[j][3] * v[j][3]); }
        const float rs = rsqrtf(wave_sum(s) * (1.f / D) + EPS);
        u32x2* o8 = (u32x2*)(F.XN + (size_t)row * D) + lane;
#pragma unroll
        for (int j = 0; j < 4; ++j) { const f32x4 g = ((const f32x4*)F.mix_norm_g)[lane + 64 * j]; v[j] = v[j] * rs * g; u32x2 w; w.x = pk2(v[j][0], v[j][1]); w.y = pk2(v[j][2], v[j][3]); o8[64 * j] = w; }
        float xv[16];
#pragma unroll
        for (int q = 0; q < 16; ++q) xv[q] = F.x[(size_t)row * D + lane + 64 * q] * rs * gq[q];
        const float dot = w32_dot(F.lds, xv, lane);
        if ((lane & 1) == 0) { const int e = w32_col(lane); const float dtr = dot + F.dt_bias[e]; F.DT[(size_t)row * 32 + e] = dtr > 20.f ? dtr : log1pf(__expf(dtr)); }
    }
}

template <class Epi, class Hook>
__device__ __forceinline__ void dense_gemm_phase(const Frame& F, const bf16* A, int lda, const bf16* Bt, int K, int nM, int nN, const Epi& E, const Hook& H) {
#pragma unroll 1
    for (int ui = F.wg; ui < nM * nN; ui += F.G) { GUnit u; u.pm = ui / nN; u.pn = ui % nN; u.e = 0; u.a = A; u.bt = Bt; sgemm_unit(u, lda, K, nullptr, E, H, F.wave, F.lane); }
}

__device__ __forceinline__ void p2_pool(const Frame& F) {
    const size_t n8 = (size_t)T * 1024 / 8;
#pragma unroll 1
    for (size_t i = (size_t)F.wg * NTHREADS + F.tid; i < n8; i += (size_t)F.G * NTHREADS) {
        const int t = (int)(i >> 7), c = (int)(i & 127) * 8, gi = c >> 8, w = 2 << gi, pos = t % SEQ, cnt = (pos + 1 < w) ? pos + 1 : w;
        float s[8] = {0, 0, 0, 0, 0, 0, 0, 0}, u0[8] = {0, 0, 0, 0, 0, 0, 0, 0};
#pragma unroll 1
        for (int j = 0; j < cnt; ++j) { float f[8]; unpack8(*(const u32x4*)(F.U + (size_t)(t - j) * 1024 + c), f);
#pragma unroll
            for (int q = 0; q < 8; ++q) { s[q] += f[q]; if (j == 0) u0[q] = f[q]; } }
        const float inv = 1.f / (float)cnt; f32x4 lo, hi;
#pragma unroll
        for (int q = 0; q < 4; ++q) { lo[q] = s[q] * inv - u0[q]; hi[q] = s[4 + q] * inv - u0[4 + q]; }
        *(u32x4*)(F.PO + (size_t)t * 1024 + c) = pack8(lo, hi);
    }
}
__device__ __forceinline__ void p2_ssd_naive(const Frame& F) {
    LAS float* sx = (LAS float*)F.lds; LAS float* sB = sx + 128; LAS float* sC = sB + 256; LAS float* sq = sC + 256;
    const int tid = F.tid;
#pragma unroll 1
    for (int unit = F.wg; unit < NB * NH; unit += F.G) {
        const int b = unit / NH, h = unit % NH, g = h / 8, p = tid >> 3, nb = tid & 7;
        int cch = -1;
        if (tid < 64) cch = h * 64 + tid; else if (tid < 192) cch = 2048 + g * 128 + (tid - 64); else if (tid < 320) cch = 2560 + g * 128 + (tid - 192);
        float w0 = 0, w1 = 0, w2 = 0, w3 = 0, cb = 0;
        if (cch >= 0) { w0 = F.conv_w[cch]; w1 = F.conv_w[DCONV + cch]; w2 = F.conv_w[2 * DCONV + cch]; w3 = F.conv_w[3 * DCONV + cch]; cb = F.conv_b[cch]; }
        const float a = -__expf(F.a_log[h]), dsk = F.d_skip[h];
        float st[16];
#pragma unroll
        for (int i = 0; i < 16; ++i) st[i] = 0.f;
        float x1 = 0.f, x2 = 0.f, x3 = 0.f;
        __syncthreads();
#pragma unroll 1
        for (int t = 0; t < SEQ; ++t) {
            const size_t row = (size_t)(b * SEQ + t); const int buf = t & 1;
            if (cch >= 0) {
                const float x0 = bf2f(F.XBC[row * DCONV + cch]);
                float v = cb + w3 * x0 + w2 * x1 + w1 * x2 + w0 * x3; x3 = x2; x2 = x1; x1 = x0; v = siluf_(v);
                if (tid < 64) sx[buf * 64 + tid] = v; else if (tid < 192) sB[buf * 128 + tid - 64] = v; else sC[buf * 128 + tid - 192] = v;
            }
            const float dt = F.DT[row * 32 + h], dA = __expf(dt * a);
            __syncthreads();
            const float xv = sx[buf * 64 + p], dx = dt * xv; float y = 0.f;
#pragma unroll
            for (int i = 0; i < 16; ++i) { st[i] = st[i] * dA + dx * sB[buf * 128 + nb * 16 + i]; y = fmaf(sC[buf * 128 + nb * 16 + i], st[i], y); }
            y += __shfl_xor(y, 1); y += __shfl_xor(y, 2); y += __shfl_xor(y, 4);
            if (nb == 0) { const float v = (y + dsk * xv) * bf2f(F.Z[row * DIN + h * 64 + p]); F.V[row * DIN + h * 64 + p] = (bf16)f2bf(v); sq[p] = v * v; }
            __syncthreads();
            if (tid < 64) { const float ssum = wave_sum(sq[tid]); if (tid == 0) F.SS[row * 32 + h] = ssum; }
        }
        __syncthreads();
    }
}
__device__ __forceinline__ void p2a_conv_bc(const Frame& F) {
    {
        const int item = F.wg * NTHREADS + F.tid, cb = item & 127, run = item >> 7, ch0 = 2048 + cb * 8, t_start = run * 16;
        float w[4][8], bias[8];
#pragma unroll
        for (int k = 0; k < 4; ++k) { const f32x4 a = *(const f32x4*)(F.conv_w + k * DCONV + ch0), b = *(const f32x4*)(F.conv_w + k * DCONV + ch0 + 4);
#pragma unroll
            for (int i = 0; i < 4; ++i) { w[k][i] = a[i]; w[k][4 + i] = b[i]; } }
        { const f32x4 a = *(const f32x4*)(F.conv_b + ch0), b = *(const f32x4*)(F.conv_b + ch0 + 4);
#pragma unroll
            for (int i = 0; i < 4; ++i) { bias[i] = a[i]; bias[4 + i] = b[i]; } }
        float r1[8], r2[8], r3[8];
        if ((t_start & (SEQ - 1)) == 0) {
#pragma unroll
            for (int i = 0; i < 8; ++i) { r1[i] = 0.f; r2[i] = 0.f; r3[i] = 0.f; }
        } else { unpack8(*(const u32x4*)(F.XBC + (size_t)(t_start - 1) * DCONV + ch0), r1); unpack8(*(const u32x4*)(F.XBC + (size_t)(t_start - 2) * DCONV + ch0), r2); unpack8(*(const u32x4*)(F.XBC + (size_t)(t_start - 3) * DCONV + ch0), r3); }
        bf16* dst = (cb < 64 ? F.BN + (size_t)(cb >> 4) * T * 128 + (cb & 15) * 8 : F.CN + (size_t)((cb - 64) >> 4) * T * 128 + ((cb - 64) & 15) * 8);
#pragma unroll 2
        for (int j = 0; j < 16; ++j) { const int t = t_start + j; float x0[8]; unpack8(*(const u32x4*)(F.XBC + (size_t)t * DCONV + ch0), x0);
            f32x4 lo, hi;
#pragma unroll
            for (int i = 0; i < 8; ++i) { const float v = siluf_(bias[i] + w[3][i] * x0[i] + w[2][i] * r1[i] + w[1][i] * r2[i] + w[0][i] * r3[i]); if (i < 4) lo[i] = v; else hi[i - 4] = v; r3[i] = r2[i]; r2[i] = r1[i]; r1[i] = x0[i]; }
            *(u32x4*)(dst + (size_t)t * 128) = pack8(lo, hi); }
    }
    {
        const int b = F.wg >> 5, g = (F.wg >> 3) & 3, cc = 4 * (F.wg & 7) + (F.tid >> 7), n = F.tid & 127, ch = 2048 + g * 128 + n, t0 = b * SEQ + cc * 64;
        const float w0 = F.conv_w[ch], w1 = F.conv_w[DCONV + ch], w2 = F.conv_w[2 * DCONV + ch], w3 = F.conv_w[3 * DCONV + ch], cbias = F.conv_b[ch];
        float x1 = 0.f, x2 = 0.f, x3 = 0.f;
        if (cc != 0) { x1 = bf2f(F.XBC[(size_t)(t0 - 1) * DCONV + ch]); x2 = bf2f(F.XBC[(size_t)(t0 - 2) * DCONV + ch]); x3 = bf2f(F.XBC[(size_t)(t0 - 3) * DCONV + ch]); }
        bf16* dst = F.BT + ((size_t)((b * 32 + cc) * 4 + g) * 128 + n) * 64;
#pragma unroll 1
        for (int blk = 0; blk < 8; ++blk) { float v[8];
#pragma unroll
            for (int i = 0; i < 8; ++i) { const float x0 = bf2f(F.XBC[(size_t)(t0 + blk * 8 + i) * DCONV + ch]); v[i] = siluf_(cbias + w3 * x0 + w2 * x1 + w1 * x2 + w0 * x3); x3 = x2; x2 = x1; x1 = x0; }
            *(u32x4*)(dst + blk * 8) = pack8((f32x4){v[0], v[1], v[2], v[3]}, (f32x4){v[4], v[5], v[6], v[7]}); }
    }
}

namespace ssd {
constexpr int BUFSZ = 58368, O_BN = 0, O_CN = 16384, O_BT = 32768, O_RAW = 49152;
constexpr int O_XT = 116736, O_XWT = 124928, O_MM = 133120, O_HB = 141312, O_DT = 157696, O_A2 = 157952, O_SSP = 158208;
__device__ __forceinline__ bf16x8 frag256(const LAS unsigned char* tile, int row, int c) { return *(const LAS bf16x8*)(tile + row * 256 + ((c ^ (row & 15)) << 4)); }
__device__ __forceinline__ bf16x8 frag128(const LAS unsigned char* tile, int row, int c) { return *(const LAS bf16x8*)(tile + row * 128 + ((c ^ ((row >> 1) & 7)) << 4)); }
#define SSD_BAR() do { asm volatile("s_waitcnt lgkmcnt(0)" ::: "memory"); __builtin_amdgcn_s_barrier(); asm volatile("" ::: "memory"); } while (0)
#define SSD_GLDS(gp, ldsoff) __builtin_amdgcn_global_load_lds((const unsigned*)(gp), (LAS unsigned*)(lds + (ldsoff)), 16, 0, 0)
}
__device__ __forceinline__ void ssd_issue(LAS unsigned char* lds, const bf16* BNg, const bf16* CNg, const bf16* BT, const bf16* XBC, int b, int g, int h, int c, int w, int lane) {
    using namespace ssd;
    const int t0 = b * SEQ + c * 64; const int bo = (c & 1) * BUFSZ;
#pragma unroll
    for (int jj = 0; jj < 2; ++jj) { const int j = 2 * w + jj;
        { const int row = 4 * j + (lane >> 4), ck = (lane & 15) ^ (row & 15);
          SSD_GLDS(BNg + (size_t)(t0 + row) * 128 + ck * 8, bo + O_BN + j * 1024); SSD_GLDS(CNg + (size_t)(t0 + row) * 128 + ck * 8, bo + O_CN + j * 1024); }
        { const int row = 8 * j + (lane >> 3), ck = (lane & 7) ^ ((row >> 1) & 7);
          SSD_GLDS(BT + ((size_t)((b * 32 + c) * 4 + g) * 128 + row) * 64 + ck * 8, bo + O_BT + j * 1024); } }
    { const int row = 8 * w + (lane >> 3); SSD_GLDS(XBC + (size_t)(t0 - 3 + row) * DCONV + h * 64 + (lane & 7) * 8, bo + O_RAW + w * 1024); }
    if (w == 0) { const int row = 64 + (lane >> 3); SSD_GLDS(XBC + (size_t)(t0 - 3 + row) * DCONV + h * 64 + (lane & 7) * 8, bo + O_RAW + 8 * 1024); }
}
__device__ __forceinline__ void p2b_ssd(const Frame& F) {
    using namespace ssd;
    LAS unsigned char* lds = F.lds;
    const int lane = F.lane, w = F.wave, fr = lane & 15, fq = lane >> 4;
    const int xs = F.wg & 7, wi = F.wg >> 3, gi = (wi >> 3) + 4 * xs, b = gi >> 2, g = gi & 3, h = g * 8 + (wi & 7);
    const float a_l2 = -__expf(F.a_log[h]) * 1.44269504f, dsk = F.d_skip[h];
    const int chx = h * 64 + lane;
    const float cw0 = F.conv_w[chx], cw1 = F.conv_w[DCONV + chx], cw2 = F.conv_w[2 * DCONV + chx], cw3 = F.conv_w[3 * DCONV + chx], cbias = F.conv_b[chx];
    const bf16* BNg = F.BN + (size_t)g * T * 128; const bf16* CNg = F.CN + (size_t)g * T * 128;
    f32x4 hacc[4];
#pragma unroll
    for (int i = 0; i < 4; ++i) hacc[i] = (f32x4){0.f, 0.f, 0.f, 0.f};
    ssd_issue(lds, BNg, CNg, F.BT, F.XBC, b, g, h, 0, w, lane);
    float dt_next = (w == 0) ? F.DT[(size_t)(b * SEQ + lane) * 32 + h] : 0.f;
#pragma unroll 1
    for (int c = 0; c < 32; ++c) {
        const int t0 = b * SEQ + c * 64; const LAS unsigned char* ib = lds + (c & 1) * BUFSZ;
        asm volatile("s_waitcnt vmcnt(0)" ::: "memory"); SSD_BAR();
        if (c + 1 < 32) ssd_issue(lds, BNg, CNg, F.BT, F.XBC, b, g, h, c + 1, w, lane);
        const int lt = w >> 1, ptb = 2 * (w & 1);
        u32x2 zq[2];
#pragma unroll
        for (int i = 0; i < 2; ++i) zq[i] = *(const u32x2*)(F.Z + (size_t)(t0 + 16 * lt + fr) * DIN + h * 64 + 16 * (ptb + i) + 4 * fq);
        if (w == 0) {
            const float dtv = dt_next; float v = dtv * a_l2;
#pragma unroll
            for (int o = 1; o < 64; o <<= 1) { const float u = __shfl_up(v, o); if (lane >= o) v += u; }
            *(LAS float*)(lds + O_DT + lane * 4) = dtv; *(LAS float*)(lds + O_A2 + lane * 4) = v;
            if (c + 1 < 32) dt_next = F.DT[(size_t)(t0 + 64 + lane) * 32 + h];
        } else if (w == 1 && c > 0) {
            F.SS[(size_t)(t0 - 64 + lane) * 32 + h] = *(const LAS float*)(lds + O_SSP + lane * 4) + *(const LAS float*)(lds + O_SSP + 256 + lane * 4);
        }
#pragma unroll
        for (int pt = 0; pt < 4; ++pt) { const int p = 16 * pt + fr; u32x2 q; q.x = pk2(hacc[pt][0], hacc[pt][1]); q.y = pk2(hacc[pt][2], hacc[pt][3]);
            *(LAS u32x2*)(lds + O_HB + p * 256 + (((2 * w + (fq >> 1)) ^ (p & 15)) << 4) + (fq & 1) * 8) = q; }
        SSD_BAR();
        {
            const LAS unsigned char* raw = ib + O_RAW; float rv[11];
#pragma unroll
            for (int i = 0; i < 11; ++i) rv[i] = bf2f(*(const LAS bf16*)(raw + (8 * w + i) * 128 + lane * 2));
            if (c == 0 && w == 0) { rv[0] = 0.f; rv[1] = 0.f; rv[2] = 0.f; }
            const f32x4 d0 = *(const LAS f32x4*)(lds + O_DT + 32 * w), d1 = *(const LAS f32x4*)(lds + O_DT + 32 * w + 16);
            const f32x4 e0 = *(const LAS f32x4*)(lds + O_A2 + 32 * w), e1 = *(const LAS f32x4*)(lds + O_A2 + 32 * w + 16);
            const float a63 = *(const LAS float*)(lds + O_A2 + 63 * 4);
            f32x4 xa, xb, wa, wb;
#pragma unroll
            for (int i = 0; i < 8; ++i) { const float xc = siluf_(cbias + cw3 * rv[i + 3] + cw2 * rv[i + 2] + cw1 * rv[i + 1] + cw0 * rv[i]);
                const float dd = i < 4 ? d0[i] : d1[i - 4], aa = i < 4 ? e0[i] : e1[i - 4]; const float xd = xc * dd, xw = xd * __builtin_amdgcn_exp2f(a63 - aa);
                if (i < 4) { xa[i] = xd; wa[i] = xw; } else { xb[i - 4] = xd; wb[i - 4] = xw; } }
            const int so = lane * 128 + ((w ^ ((lane >> 1) & 7)) << 4);
            *(LAS u32x4*)(lds + O_XT + so) = pack8(xa, xb); *(LAS u32x4*)(lds + O_XWT + so) = pack8(wa, wb);
        }
        {
            const int l = 16 * lt + fr; const float a2l = *(const LAS float*)(lds + O_A2 + l * 4), ddl = dsk / *(const LAS float*)(lds + O_DT + l * 4);
#pragma unroll
            for (int i = 0; i < 2; ++i) { const int st = ptb + i; f32x4 cb = (f32x4){0.f, 0.f, 0.f, 0.f};
                if (st <= lt) {
#pragma unroll
                    for (int ks = 0; ks < 4; ++ks) cb = __builtin_amdgcn_mfma_f32_16x16x32_bf16(frag256(ib + O_BN, 16 * st + fr, 4 * ks + fq), frag256(ib + O_CN, l, 4 * ks + fq), cb, 0, 0, 0);
                    const f32x4 a2s = *(const LAS f32x4*)(lds + O_A2 + (16 * st + 4 * fq) * 4);
#pragma unroll
                    for (int r = 0; r < 4; ++r) { const int sx = 16 * st + 4 * fq + r; float m = cb[r] * __builtin_amdgcn_exp2f(a2l - a2s[r]); m = (l >= sx) ? m : 0.f; if (l == sx) m += ddl; cb[r] = m; }
                }
                u32x2 q; q.x = pk2(cb[0], cb[1]); q.y = pk2(cb[2], cb[3]);
                *(LAS u32x2*)(lds + O_MM + l * 128 + (((2 * st + (fq >> 1)) ^ ((l >> 1) & 7)) << 4) + (fq & 1) * 8) = q; }
        }
        SSD_BAR();
        {
            const int l = 16 * lt + fr; f32x4 ya[2] = {(f32x4){0.f, 0.f, 0.f, 0.f}, (f32x4){0.f, 0.f, 0.f, 0.f}};
#pragma unroll
            for (int ks = 0; ks < 4; ++ks) { const bf16x8 yf = frag256(ib + O_CN, l, 4 * ks + fq);
#pragma unroll
                for (int i = 0; i < 2; ++i) ya[i] = __builtin_amdgcn_mfma_f32_16x16x32_bf16(frag256(lds + O_HB, 16 * (ptb + i) + fr, 4 * ks + fq), yf, ya[i], 0, 0, 0); }
            const float el = __builtin_amdgcn_exp2f(*(const LAS float*)(lds + O_A2 + l * 4));
            ya[0] *= el; ya[1] *= el;
#pragma unroll
            for (int ks = 0; ks < 2; ++ks) if (32 * ks <= 16 * lt + 15) { const bf16x8 yf = frag128(lds + O_MM, l, 4 * ks + fq);
#pragma unroll
                for (int i = 0; i < 2; ++i) ya[i] = __builtin_amdgcn_mfma_f32_16x16x32_bf16(frag128(lds + O_XT, 16 * (ptb + i) + fr, 4 * ks + fq), yf, ya[i], 0, 0, 0); }
            float ssq = 0.f;
#pragma unroll
            for (int i = 0; i < 2; ++i) { const float z0 = bf2f(zq[i].x & 0xffffu), z1 = bf2f(zq[i].x >> 16), z2 = bf2f(zq[i].y & 0xffffu), z3 = bf2f(zq[i].y >> 16);
                const float v0 = ya[i][0] * z0, v1 = ya[i][1] * z1, v2 = ya[i][2] * z2, v3 = ya[i][3] * z3; ssq += (v0 * v0 + v1 * v1) + (v2 * v2 + v3 * v3);
                u32x2 q; q.x = pk2(v0, v1); q.y = pk2(v2, v3); *(u32x2*)(F.V + (size_t)(t0 + l) * DIN + h * 64 + 16 * (ptb + i) + 4 * fq) = q; }
            ssq += __shfl_xor(ssq, 16); ssq += __shfl_xor(ssq, 32);
            if (fq == 0) *(LAS float*)(lds + O_SSP + (w & 1) * 256 + l * 4) = ssq;
        }
        {
            const float ed = __builtin_amdgcn_exp2f(*(const LAS float*)(lds + O_A2 + 63 * 4));
#pragma unroll
            for (int pt = 0; pt < 4; ++pt) hacc[pt] *= ed;
#pragma unroll
            for (int ks = 0; ks < 2; ++ks) { const bf16x8 xf = frag128(ib + O_BT, 16 * w + fr, 4 * ks + fq);
#pragma unroll
                for (int pt = 0; pt < 4; ++pt) hacc[pt] = __builtin_amdgcn_mfma_f32_16x16x32_bf16(xf, frag128(lds + O_XWT, 16 * pt + fr, 4 * ks + fq), hacc[pt], 0, 0, 0); }
        }
    }
    SSD_BAR();
    if (w == 1) F.SS[(size_t)(b * SEQ + 31 * 64 + lane) * 32 + h] = *(const LAS float*)(lds + O_SSP + lane * 4) + *(const LAS float*)(lds + O_SSP + 256 + lane * 4);
    asm volatile("s_waitcnt vmcnt(0)" ::: "memory"); SSD_BAR();
}

__device__ __forceinline__ void p3_rstd(const Frame& F) {
#pragma unroll 1
    for (int t = F.wg * NTHREADS + F.tid; t < T; t += F.G * NTHREADS) { float r[4];
#pragma unroll
        for (int g = 0; g < 4; ++g) { float s = 0.f;
#pragma unroll
            for (int q = 0; q < 8; ++q) s += F.SS[(size_t)t * 32 + g * 8 + q];
            r[g] = rsqrtf(s * (1.f / 512.f) + EPS); }
        *(f32x4*)(F.RSTD + (size_t)t * 4) = (f32x4){r[0] / r[1], r[1] / r[2], r[2] / r[3], r[3]}; }
}
__device__ __forceinline__ void p6_router(const Frame& F) {
    LAS int* cnt = (LAS int*)(F.lds + O_W32_CNT);
    const int lane = F.lane;
    w32_fill(F, F.w_router, 32);
    if (F.tid < 32) cnt[F.tid] = 0;
    float gq[16];
#pragma unroll
    for (int q = 0; q < 16; ++q) gq[q] = F.ffn_norm_g[lane + 64 * q];
    __syncthreads();
    LAS float* lscr = (LAS float*)(F.lds + O_W32_SCR + F.wave * 128);
#pragma unroll 1
    for (int rr = 0; rr < 8; ++rr) {
        const int row = F.wg * 64 + F.wave * 8 + rr;
        const f32x4* xr = (const f32x4*)(F.out + (size_t)row * D) + lane;
        f32x4 v[4]; float s = 0.f;
#pragma unroll
        for (int j = 0; j < 4; ++j) { v[j] = xr[64 * j]; s += (v[j][0] * v[j][0] + v[j][1] * v[j][1]) + (v[j][2] * v[j][2] + v[j][3] * v[j][3]); }
        const float rs = rsqrtf(wave_sum(s) * (1.f / D) + EPS);
        u32x2* o8 = (u32x2*)(F.XN + (size_t)row * D) + lane;
#pragma unroll
        for (int j = 0; j < 4; ++j) { const f32x4 g = ((const f32x4*)F.ffn_norm_g)[lane + 64 * j]; v[j] = v[j] * rs * g; u32x2 w; w.x = pk2(v[j][0], v[j][1]); w.y = pk2(v[j][2], v[j][3]); o8[64 * j] = w; }
        float xv[16];
#pragma unroll
        for (int q = 0; q < 16; ++q) xv[q] = F.out[(size_t)row * D + lane + 64 * q] * rs * gq[q];
        const float dot = w32_dot(F.lds, xv, lane);
        if ((lane & 1) == 0) { const int e = w32_col(lane); lscr[e] = dot + F.b_router[e]; }
        asm volatile("s_waitcnt lgkmcnt(0)" ::: "memory");
        float lg[32];
#pragma unroll
        for (int q = 0; q < 8; ++q) { const f32x4 t4 = *(const LAS f32x4*)(lscr + 4 * q); lg[4 * q] = t4[0]; lg[4 * q + 1] = t4[1]; lg[4 * q + 2] = t4[2]; lg[4 * q + 3] = t4[3]; }
        asm volatile("s_waitcnt lgkmcnt(0)" ::: "memory");
        float tv[4]; int ti[4];
#pragma unroll
        for (int k = 0; k < 4; ++k) { float best = -INFINITY; int bi = 0;
#pragma unroll
            for (int e = 0; e < 32; ++e) if (lg[e] > best) { best = lg[e]; bi = e; }
            tv[k] = best; ti[k] = bi;
#pragma unroll
            for (int e = 0; e < 32; ++e) if (e == bi) lg[e] = -INFINITY; }
        float ex[4], se = 0.f;
#pragma unroll
        for (int k = 0; k < 4; ++k) { ex[k] = __expf(tv[k] - tv[0]); se += ex[k]; }
        if (lane == 0) {
#pragma unroll
            for (int k = 0; k < 4; ++k) { F.TIDX[row * 4 + k] = ti[k]; F.TW[row * 4 + k] = ex[k] / se; __hip_atomic_fetch_add(cnt + ti[k], 1, __ATOMIC_RELAXED, __HIP_MEMORY_SCOPE_WORKGROUP); } }
    }
    __syncthreads();
    if (F.tid < 32) F.CNT[F.wg * 32 + F.tid] = cnt[F.tid];
}
__device__ __forceinline__ void p7_route(const Frame& F) {
    LAS int* base = (LAS int*)F.lds; LAS int* tot = base + 32; LAS int* pstart = tot + 32; LAS int* wcnt = pstart + 64;
    const int tid = F.tid, lane = F.lane;
    if (tid < 64) base[tid] = 0;
    __syncthreads();
    { const int e = tid & 31, w0 = 16 * (tid >> 5); int tt = 0, bb = 0;
#pragma unroll
      for (int i = 0; i < 16; ++i) { const int c = F.CNT[(w0 + i) * 32 + e]; tt += c; bb += (w0 + i < F.wg) ? c : 0; }
      __hip_atomic_fetch_add(tot + e, tt, __ATOMIC_RELAXED, __HIP_MEMORY_SCOPE_WORKGROUP); __hip_atomic_fetch_add(base + e, bb, __ATOMIC_RELAXED, __HIP_MEMORY_SCOPE_WORKGROUP); }
    int e_mine = 0, lr = 0;
    if (tid < 256) {
        e_mine = F.TIDX[F.wg * 256 + tid];
        const unsigned long long lt_mask = (1ull << lane) - 1ull;
#pragma unroll 1
        for (int q = 0; q < 32; ++q) { const unsigned long long m = __ballot(e_mine == q); if (e_mine == q) lr = __popcll(m & lt_mask); if (lane == 0) wcnt[F.wave * 32 + q] = __popcll(m); }
    }
    __syncthreads();
    if (tid == 0) { int sacc = 0;
#pragma unroll 1
        for (int e = 0; e < 32; ++e) { pstart[e] = sacc; sacc += (tot[e] + 255) / 256 * 256; } pstart[32] = sacc; }
    __syncthreads();
    if (tid < 256) { int off = 0;
#pragma unroll
        for (int w = 0; w < 3; ++w) off += (w < F.wave) ? wcnt[w * 32 + e_mine] : 0;
        const int d = pstart[e_mine] + base[e_mine] + off + lr; F.DEST[F.wg * 256 + tid] = d; F.ROWTOK[d] = F.wg * 64 + (tid >> 2); }
    if (F.wg < 32) { const int e = F.wg;
#pragma unroll 1
        for (int r = pstart[e] + tot[e] + tid; r < pstart[e + 1]; r += NTHREADS) F.ROWTOK[r] = 0; }
    if (F.wg == 0 && tid < 33) F.PSTART[tid] = pstart[tid];
    if (F.wg == 0 && tid < MAXROWS / 256) { int e = 0;
#pragma unroll 1
        for (int q = 1; q < 32; ++q) if (tid * 256 >= pstart[q]) e = q;
        F.TILE_E[tid] = e; }
}
__device__ __forceinline__ int expert_of_row(const int* ps, int row) { int e = 0;
#pragma unroll 1
    for (int q = 1; q < 32; ++q) if (row >= ps[q]) e = q;
    return e; }
__device__ __forceinline__ void p8_moe_gu(const Frame& F) {
    const int nrt = F.PSTART[32] / 256; const EpiGU E{F.ACT, F.b_gate_up}; const NoHook H;
#pragma unroll 1
    for (int ui = F.wg; ui < nrt * 8; ui += F.G) { GUnit u; u.pm = ui >> 3; u.pn = ui & 7; u.e = expert_of_row(F.PSTART, u.pm * 256); u.a = F.XN; u.bt = F.WGU + (size_t)u.e * 2048 * 1024;
        sgemm_unit(u, 1024, 1024, F.ROWTOK, E, H, F.wave, F.lane); }
}
__device__ __forceinline__ void p9_moe_dn(const Frame& F) {
    const int nrt = F.PSTART[32] / 256; const EpiDN E{F.YR, F.b_down}; const NoHook H;
#pragma unroll 1
    for (int ui = F.wg; ui < nrt * 4; ui += F.G) { GUnit u; u.pm = ui >> 2; u.pn = ui & 3; u.e = expert_of_row(F.PSTART, u.pm * 256); u.a = F.ACT; u.bt = F.WDN + (size_t)u.e * 1024 * 1024;
        sgemm_unit(u, 1024, 1024, nullptr, E, H, F.wave, F.lane); }
}
__device__ __forceinline__ void p10_combine(const Frame& F) {
    const int gw = F.wg * NWAVES + F.wave, NGW = F.G * NWAVES, lane = F.lane;
#pragma unroll 1
    for (int row = gw; row < T; row += NGW) {
        f32x4* xr = (f32x4*)(F.out + (size_t)row * D) + lane;
        f32x4 v[4];
#pragma unroll
        for (int j = 0; j < 4; ++j) v[j] = xr[64 * j];
#pragma unroll
        for (int k = 0; k < 4; ++k) { const int d = F.DEST[row * 4 + k]; const float w = F.TW[row * 4 + k]; const u32x2* yr = (const u32x2*)(F.YR + (size_t)d * 1024) + lane;
#pragma unroll
            for (int j = 0; j < 4; ++j) { const u32x2 q = yr[64 * j]; v[j][0] += w * bf2f(q.x & 0xffffu); v[j][1] += w * bf2f(q.x >> 16); v[j][2] += w * bf2f(q.y & 0xffffu); v[j][3] += w * bf2f(q.y >> 16); } }
        float s = 0.f;
#pragma unroll
        for (int j = 0; j < 4; ++j) { xr[64 * j] = v[j]; s += (v[j][0] * v[j][0] + v[j][1] * v[j][1]) + (v[j][2] * v[j][2] + v[j][3] * v[j][3]); }
        const float rs = rsqrtf(wave_sum(s) * (1.f / D) + EPS);
        u32x2* o8 = (u32x2*)(F.XN + (size_t)row * D) + lane;
#pragma unroll
        for (int j = 0; j < 4; ++j) { const f32x4 g = ((const f32x4*)F.ple_norm_g)[lane + 64 * j]; const f32x4 q = v[j] * rs * g; u32x2 w; w.x = pk2(q[0], q[1]); w.y = pk2(q[2], q[3]); o8[64 * j] = w; }
    }
}
__device__ __forceinline__ void p12_final(const Frame& F) {
    const int gw = F.wg * NWAVES + F.wave, NGW = F.G * NWAVES, lane = F.lane;
#pragma unroll 1
    for (int row = gw; row < T; row += NGW) {
        f32x4* xr = (f32x4*)(F.out + (size_t)row * D) + lane; f32x4 v[4]; float s = 0.f;
#pragma unroll
        for (int j = 0; j < 4; ++j) { v[j] = xr[64 * j]; s += (v[j][0] * v[j][0] + v[j][1] * v[j][1]) + (v[j][2] * v[j][2] + v[j][3] * v[j][3]); }
        const float rs = rsqrtf(wave_sum(s) * (1.f / D) + EPS);
#pragma unroll
        for (int j = 0; j < 4; ++j) { const f32x4 g = ((const f32x4*)F.final_norm_g)[lane + 64 * j]; xr[64 * j] = v[j] * rs * g; }
    }
}

constexpr int LDS_BYTES = 163840;
constexpr int MISC_OFF = 162816;

__global__ void __launch_bounds__(NTHREADS, 2) mk_fwd(Args args) {
    extern __shared__ __attribute__((aligned(16))) unsigned char lds_raw[];
    Frame F;
    F.lds = (LAS unsigned char*)lds_raw; F.tid = threadIdx.x; F.lane = F.tid & 63; F.wave = __builtin_amdgcn_readfirstlane(F.tid >> 6); F.G = gridDim.x; F.wg = blockIdx.x;
    unsigned char* ws = args.ws;
    F.x = args.in[0]; F.p = args.in[1]; F.mix_norm_g = args.in[2]; F.w_in = args.in[3]; F.conv_w = args.in[4]; F.conv_b = args.in[5]; F.dt_bias = args.in[6]; F.a_log = args.in[7]; F.d_skip = args.in[8];
    F.ssd_norm_g = args.in[9]; F.w_ssd_out = args.in[10]; F.pool_w = args.in[11]; F.pool_scale = args.in[12]; F.w_mix_out = args.in[13]; F.ffn_norm_g = args.in[14]; F.w_router = args.in[15];
    F.b_router = args.in[16]; F.w_gate_up = args.in[17]; F.b_gate_up = args.in[18]; F.w_down = args.in[19]; F.b_down = args.in[20]; F.ple_norm_g = args.in[21]; F.w_ple_gate = args.in[22];
    F.w_ple_proj = args.in[23]; F.final_norm_g = args.in[24]; F.out = args.out;
    F.WIN = (bf16*)(ws + WS_WIN); F.WOUT = (bf16*)(ws + WS_WOUT); F.WPOOL = (bf16*)(ws + WS_WPOOL); F.WMIX = (bf16*)(ws + WS_WMIX); F.WPG = (bf16*)(ws + WS_WPG); F.WPP = (bf16*)(ws + WS_WPP);
    F.WGU = (bf16*)(ws + WS_WGU); F.WDN = (bf16*)(ws + WS_WDN); F.XN = (bf16*)(ws + WS_XN); F.PO = (bf16*)(ws + WS_PO); F.YPG = (bf16*)(ws + WS_YPG); F.MIXED = (bf16*)(ws + WS_MIXED);
    F.PB = (bf16*)(ws + WS_PB); F.Z = (bf16*)(ws + WS_Z); F.XBC = (bf16*)(ws + WS_XBC); F.U = (bf16*)(ws + WS_U); F.GT = (bf16*)(ws + WS_GT); F.V = (bf16*)(ws + WS_V);
    F.ACT = (bf16*)(ws + WS_ACT); F.YR = (bf16*)(ws + WS_YR); F.DT = (float*)(ws + WS_DT); F.SS = (float*)(ws + WS_SS); F.RSTD = (float*)(ws + WS_RSTD); F.TMP = (float*)(ws + WS_TMP); F.BN = (bf16*)(ws + WS_BN); F.CN = (bf16*)(ws + WS_CN); F.BT = (bf16*)(ws + WS_BT);
    { unsigned char* r = ws + WS_ROUTE; F.TIDX = (int*)r; r += NA * 4; F.TW = (float*)r; r += NA * 4; F.DEST = (int*)r; r += NA * 4; F.ROWTOK = (int*)r; r += MAXROWS * 4; F.CNT = (int*)r; r += 256 * 32 * 4; F.PSTART = (int*)r; r += 256; F.TILE_E = (int*)r; }

    volatile LAS unsigned* MISC = (volatile LAS unsigned*)(F.lds + MISC_OFF);
    if (F.tid < 64) MISC[F.tid] = 0u;
    __syncthreads();
    const int lo = args.ph_lo, hi = args.ph_hi;
    XcdBarrier bar; bar.bar = (unsigned*)(ws + WS_CTL) + CW_BAR; bar.x = 0; bar.st = nullptr;
    if (hi - lo > 1) bar = xcd_barrier_post((unsigned*)(ws + WS_CTL) + CW_BAR, MISC + 8);
#define IN(k) (lo <= (k) && (k) < hi)
#define SEAM(k) do { if (IN(k) && IN((k) + 1)) xcd_barrier(bar); } while (0)
    const NoHook NH_; const NoHookPg NHP;
    LAS unsigned char* ring = F.lds;
#define PG(k) ((PGMASK >> (k)) & 1)
    if (IN(0)) { p0_prologue(F); } SEAM(0);
    if (IN(1)) { const EpiInproj E{F.Z, F.XBC, F.U, F.GT};
        if (PG(1)) { const DenseOrder S{64, 32, 64 * 32, F.G, F.wg, F.XN, F.WIN}; pg::gemm_phase<EpiInproj, DenseOrder, NoHookPg, true, false>(ring, 1024, 1024, nullptr, S, E, NHP); }
        else dense_gemm_phase(F, F.XN, 1024, F.WIN, 1024, 64, 32, E, NH_); } SEAM(1);
    if (IN(2)) { p2a_conv_bc(F); p2_pool(F); } SEAM(2);
    if (IN(3)) { if (SSD_FAST) p2b_ssd(F); else p2_ssd_naive(F); } SEAM(3);
    if (IN(4)) { p3_rstd(F); const EpiPool E{F.YPG, F.GT};
        if (PG(4)) { __syncthreads(); const PoolOrder S{F.G, F.wg, F.PO, F.WPOOL}; pg::gemm_phase<EpiPool, PoolOrder, NoHookPg, false, false>(ring, 1024, 256, nullptr, S, E, NHP); }
        else {
#pragma unroll 1
        for (int ui = F.wg; ui < 64 * 4; ui += F.G) { GUnit u; u.pm = ui >> 2; u.pn = 0; u.e = ui & 3; u.a = F.PO + 256 * u.e; u.bt = F.WPOOL + (size_t)u.e * 65536; sgemm_unit(u, 1024, 256, nullptr, E, NH_, F.wave, F.lane); } } } SEAM(4);
    if (IN(5)) { const EpiOut E{F.MIXED, F.GT, F.YPG};
        if (PG(5)) { const DenseOrder S{64, 4, 256, F.G, F.wg, F.V, F.WOUT}; GUnit u0; LAS float* tab = (LAS float*)(F.lds + 131072 + 1024);
            if (S.next(0, u0) && F.tid < 256) { const f32x4 r = *(const f32x4*)(F.RSTD + (size_t)(u0.pm * 256 + F.tid) * 4); *(LAS f32x4*)(tab + F.tid * 4) = r; }
            __syncthreads();
            const RatioHook H{tab}; pg::gemm_phase<EpiOut, DenseOrder, RatioHook, false, false>(ring, 2048, 2048, nullptr, S, E, H); }
        else { const RstdHook H{F.RSTD}; dense_gemm_phase(F, F.V, 2048, F.WOUT, 2048, 64, 4, E, H); } } SEAM(5);
    if (IN(6)) { const EpiMix E{F.x, F.out};
        if (PG(6)) { const DenseOrder S{64, 4, 256, F.G, F.wg, F.MIXED, F.WMIX}; pg::gemm_phase<EpiMix, DenseOrder, NoHookPg, false, false>(ring, 1024, 1024, nullptr, S, E, NHP); }
        else dense_gemm_phase(F, F.MIXED, 1024, F.WMIX, 1024, 64, 4, E, NH_); } SEAM(6);
    if (IN(7)) { p6_router(F); } SEAM(7);
    if (IN(8)) { p7_route(F); } SEAM(8);
    if (IN(9)) { if (PG(9)) { const EpiGU E{F.ACT, F.b_gate_up}; const MoeOrder<8, 2048> S{F.G, F.wg, F.PSTART[32] / 256, F.TILE_E, F.XN, F.WGU};
            pg::gemm_phase<EpiGU, MoeOrder<8, 2048>, NoHookPg, true, true>(ring, 1024, 1024, F.ROWTOK, S, E, NHP); }
        else p8_moe_gu(F); } SEAM(9);
    if (IN(10)) { if (PG(10)) { const EpiDN E{F.YR, F.b_down}; const MoeOrder<4, 1024> S{F.G, F.wg, F.PSTART[32] / 256, F.TILE_E, F.ACT, F.WDN};
            pg::gemm_phase<EpiDN, MoeOrder<4, 1024>, NoHookPg, true, false>(ring, 1024, 1024, nullptr, S, E, NHP); }
        else p9_moe_dn(F); } SEAM(10);
    if (IN(11)) { p10_combine(F); } SEAM(11);
    if (IN(12)) { const EpiF32 E1{F.TMP}; const EpiPle E2{F.TMP, F.out};
        if (PG(12)) { const DenseOrder S1{64, 4, 256, F.G, F.wg, F.PB, F.WPP}; pg::gemm_phase<EpiF32, DenseOrder, NoHookPg, false, false>(ring, 256, 256, nullptr, S1, E1, NHP);
            asm volatile("s_waitcnt vmcnt(0)" ::: "memory"); __syncthreads();
            const DenseOrder S2{64, 4, 256, F.G, F.wg, F.XN, F.WPG}; pg::gemm_phase<EpiPle, DenseOrder, NoHookPg, false, false>(ring, 1024, 1024, nullptr, S2, E2, NHP); }
        else {
#pragma unroll 1
        for (int ui = F.wg; ui < 64 * 4; ui += F.G) { GUnit u; u.pm = ui >> 2; u.pn = ui & 3; u.e = 0; u.a = F.PB; u.bt = F.WPP; sgemm_unit(u, 256, 256, nullptr, E1, NH_, F.wave, F.lane);
            asm volatile("s_waitcnt vmcnt(0)" ::: "memory"); __syncthreads();
            u.a = F.XN; u.bt = F.WPG; sgemm_unit(u, 1024, 1024, nullptr, E2, NH_, F.wave, F.lane); } } } SEAM(12);
    if (IN(13)) { p12_final(F); }
#undef PG
#undef IN
#undef SEAM
}
}

extern "C" void kernel_launch(void* const* d_in, const int* in_sizes, int n_in, void* d_out, int out_size, void* d_ws, size_t ws_size, hipStream_t stream) {
    static int grid = 0;
    if (grid == 0) {
        if (n_in != 25 || in_sizes[0] != T * D || out_size != T * D || ws_size < WS_END) { fprintf(stderr, "kernel_launch: unexpected shapes (n_in %d, out %d, ws %zu)\n", n_in, out_size, ws_size); grid = -1; return; }
        int dev = 0, cus = 0, per_cu = 0;
        if (hipGetDevice(&dev) != hipSuccess || hipDeviceGetAttribute(&cus, hipDeviceAttributeMultiprocessorCount, dev) != hipSuccess) { grid = -1; return; }
        if (hipFuncSetAttribute((const void*)mk_fwd, hipFuncAttributeMaxDynamicSharedMemorySize, LDS_BYTES) != hipSuccess) { fprintf(stderr, "kernel_launch: hipFuncSetAttribute failed\n"); grid = -1; return; }
        if (hipOccupancyMaxActiveBlocksPerMultiprocessor(&per_cu, (const void*)mk_fwd, NTHREADS, LDS_BYTES) != hipSuccess || per_cu < 1) { fprintf(stderr, "kernel_launch: occupancy query says %d blocks/CU\n", per_cu); (void)hipGetLastError(); grid = -1; return; }
        grid = cus;
        if (grid != 256) { fprintf(stderr, "kernel_launch: built for a 256-CU device, found %d CUs\n", cus); grid = -1; return; }
    }
    if (grid < 0) return;
    (void)hipMemsetAsync((char*)d_ws + WS_CTL, 0, CTL_ZERO_BYTES, stream);
    Args a; memset(&a, 0, sizeof(a));
    for (int i = 0; i < 25; ++i) a.in[i] = (const float*)d_in[i];
    a.out = (float*)d_out; a.ws = (unsigned char*)d_ws;
#if MK_MULTI
    for (int ph = 0; ph < NPH; ++ph) { a.ph_lo = ph; a.ph_hi = ph + 1; hipLaunchKernelGGL(mk_fwd, dim3(grid), dim3(NTHREADS), LDS_BYTES, stream, a); }
#else
    a.ph_lo = 0; a.ph_hi = NPH;
    void* kargs[] = {&a};
    hipError_t e = hipLaunchCooperativeKernel((const void*)mk_fwd, dim3(grid), dim3(NTHREADS), kargs, LDS_BYTES, stream);
    if (e != hipSuccess) fprintf(stderr, "kernel_launch: cooperative launch failed: %s\n", hipGetErrorString(e));
#endif
}
```

```cpp
#include <hip/hip_runtime.h>
#include <cstdio>
#include <cstdint>
#include <cstring>

#ifndef PGMASK
#define PGMASK 0x1672
#endif
#ifndef REP_PH
#define REP_PH (-1)
#endif
#ifndef REP_SUB
#define REP_SUB 0
#endif
#ifndef SSD_FAST
#define SSD_FAST 1
#endif
#ifndef MK_MULTI
#define MK_MULTI 0
#endif

#define LAS __attribute__((address_space(3)))
#define GAS __attribute__((address_space(1)))
typedef unsigned short bf16;
typedef short bf16x8 __attribute__((ext_vector_type(8)));
typedef float f32x4 __attribute__((ext_vector_type(4)));
typedef unsigned u32x4 __attribute__((ext_vector_type(4)));
typedef unsigned u32x2 __attribute__((ext_vector_type(2)));

namespace {
constexpr int T = 16384, SEQ = 2048, NB = 8, D = 1024;
constexpr int DIN = 2048, NH = 32, DCONV = 3072, NPROJ = 8224;
constexpr int NE = 32, DE = 1024, DPLE = 256;
constexpr int NA = T * 4;
constexpr int MAXROWS = NA + NE * 256;
constexpr float EPS = 1e-6f;
constexpr int NWAVES = 8, NTHREADS = 512;
constexpr int NPH = 14;
constexpr size_t MiB = 1u << 20;
constexpr size_t WS_CTL = 0, CTL_ZERO_BYTES = 1 * MiB;
constexpr size_t WS_WIN = 2 * MiB, WS_WOUT = 18 * MiB, WS_WPOOL = 22 * MiB, WS_WMIX = 23 * MiB, WS_WPG = 25 * MiB, WS_WPP = 27 * MiB;
constexpr size_t WS_WGU = 28 * MiB, WS_WDN = 156 * MiB;
constexpr size_t WS_XN = 220 * MiB, WS_DT = 252 * MiB, WS_SS = 254 * MiB, WS_RSTD = 256 * MiB, WS_PO = 257 * MiB, WS_YPG = 289 * MiB, WS_MIXED = 321 * MiB, WS_PB = 353 * MiB;
constexpr size_t WS_ROUTE = 361 * MiB;
constexpr size_t WS_Z = 364 * MiB, WS_XBC = 428 * MiB, WS_U = 524 * MiB, WS_GT = 556 * MiB, WS_V = 620 * MiB;
constexpr size_t WS_ACT = 364 * MiB, WS_YR = 508 * MiB;
constexpr size_t WS_TMP = 684 * MiB;
constexpr size_t WS_BN = 684 * MiB, WS_CN = 700 * MiB, WS_BT = 716 * MiB;
constexpr size_t WS_END = 748 * MiB;
constexpr int CW_BAR = 4096;

__device__ __forceinline__ float bf2f(unsigned v) { return __uint_as_float(v << 16); }
__device__ __forceinline__ unsigned f2bf(float f) { unsigned u = __float_as_uint(f); return (u + 0x7fffu + ((u >> 16) & 1u)) >> 16; }
__device__ __forceinline__ unsigned pk2(float lo, float hi) { unsigned r; asm volatile("v_cvt_pk_bf16_f32 %0, %1, %2" : "=v"(r) : "v"(lo), "v"(hi)); return r; }
__device__ __forceinline__ float wave_sum(float v) {
#pragma unroll
    for (int o = 1; o < 64; o <<= 1) v += __shfl_xor(v, o);
    return v;
}
__device__ __forceinline__ float sigmoidf_(float x) { return __builtin_amdgcn_rcpf(1.f + __builtin_amdgcn_exp2f(-1.44269504f * x)); }
__device__ __forceinline__ float siluf_(float x) { return x * sigmoidf_(x); }
__device__ __forceinline__ void unpack8(const u32x4 w, float (&f)[8]) {
    f[0] = bf2f(w.x & 0xffffu); f[1] = bf2f(w.x >> 16); f[2] = bf2f(w.y & 0xffffu); f[3] = bf2f(w.y >> 16);
    f[4] = bf2f(w.z & 0xffffu); f[5] = bf2f(w.z >> 16); f[6] = bf2f(w.w & 0xffffu); f[7] = bf2f(w.w >> 16);
}
__device__ __forceinline__ u32x4 pack8(const f32x4 lo, const f32x4 hi) { u32x4 w; w.x = pk2(lo[0], lo[1]); w.y = pk2(lo[2], lo[3]); w.z = pk2(hi[0], hi[1]); w.w = pk2(hi[2], hi[3]); return w; }
__host__ __device__ __forceinline__ int perm32(int rho) { const int n = rho >> 4, i = rho & 15; return 8 * (i >> 2) + 4 * n + (i & 3); }

#define XB_TMO      128
#define XB_XCNT(j)  (256  + 64 * (j))
#define XB_XSUB(j)  (1280 + 64 * (j))
#define XB_XGEN(j)  (2304 + 64 * (j))
#define XB_TOP      3328
#define XB_TOPGEN   3392
#define XCD_BAR_WORDS 3456
#define XB_SPIN_CAP (1u << 18)
__device__ __forceinline__ unsigned xb_ld(unsigned* p)              { return __hip_atomic_load(p, __ATOMIC_RELAXED, __HIP_MEMORY_SCOPE_AGENT); }
__device__ __forceinline__ unsigned xb_add(unsigned* p, unsigned v) { return __hip_atomic_fetch_add(p, v, __ATOMIC_RELAXED, __HIP_MEMORY_SCOPE_AGENT); }
__device__ __forceinline__ unsigned xb_xcc_id() { return (unsigned)__builtin_amdgcn_s_getreg((3 << 11) | 20) & 0xFu; }
#define XB_SPIN(cond, bar) do { unsigned _sp = 0; while (cond) { __builtin_amdgcn_s_sleep(1); \
    if ((++_sp & 255u) == 0u) { if (xb_ld(&(bar)[XB_TMO])) break; if (_sp > XB_SPIN_CAP) { atomicAdd(&(bar)[XB_TMO], 1u); break; } } } } while (0)
struct XcdBarrier { unsigned* bar; unsigned x; volatile LAS unsigned* st; };
__device__ __forceinline__ XcdBarrier xcd_barrier_post(unsigned* bar, volatile LAS unsigned* st) {
    XcdBarrier b; b.bar = bar; b.x = xb_xcc_id(); b.st = st;
    if (threadIdx.x == 0) (void)xb_add(&bar[XB_XCNT(b.x)], 1u);
    return b;
}
__device__ __forceinline__ void xcd_barrier_complete(unsigned* bar, unsigned x, unsigned& nloc, unsigned& nx) {
    const unsigned G = gridDim.x * gridDim.y * gridDim.z;
    unsigned sum, cnt, mine, sp = 0u;
    for (;;) {
        sum = 0u; cnt = 0u; mine = 0u;
#pragma unroll
        for (unsigned j = 0; j < 16; ++j) { const unsigned c = xb_ld(&bar[XB_XCNT(j)]); sum += c; cnt += (c > 0u) ? 1u : 0u; mine = (j == x) ? c : mine; }
        if (sum == G) break;
        __builtin_amdgcn_s_sleep(1);
        if ((++sp & 255u) == 0u) { if (xb_ld(&bar[XB_TMO])) break; if (sp > XB_SPIN_CAP) { atomicAdd(&bar[XB_TMO], 1u); break; } }
    }
    nloc = mine > 0u ? mine : 1u; nx = cnt > 0u ? cnt : 1u;
}
__device__ __forceinline__ void xcd_barrier(const XcdBarrier& b) {
    asm volatile("s_waitcnt vmcnt(0)" ::: "memory");
    __syncthreads();
    if (threadIdx.x == 0) {
        unsigned* bar = b.bar;
        __builtin_amdgcn_s_waitcnt(0);
        unsigned nloc = b.st[0], nx = b.st[1];
        if (nloc == 0u) { xcd_barrier_complete(bar, b.x, nloc, nx); b.st[0] = nloc; b.st[1] = nx; }
        const unsigned old = xb_add(&bar[XB_XSUB(b.x)], 1u);
        const unsigned gen = old / nloc;
        if (old + 1u == (gen + 1u) * nloc) {
            __builtin_amdgcn_fence(__ATOMIC_RELEASE, "agent");
            asm volatile("s_waitcnt vmcnt(0)" ::: "memory");
            const unsigned og = xb_add(&bar[XB_TOP], 1u);
            const unsigned tg = og / nx;
            if (og + 1u == (tg + 1u) * nx) xb_add(&bar[XB_TOPGEN], 1u);
            else XB_SPIN(xb_ld(&bar[XB_TOPGEN]) == tg, bar);
            __builtin_amdgcn_fence(__ATOMIC_ACQUIRE, "agent");
            xb_add(&bar[XB_XGEN(b.x)], 1u);
            asm volatile("s_waitcnt vmcnt(0)" ::: "memory");
        } else {
            XB_SPIN(xb_ld(&bar[XB_XGEN(b.x)]) == gen, bar);
            __builtin_amdgcn_fence(__ATOMIC_ACQUIRE, "agent");
            asm volatile("s_waitcnt vmcnt(0)" ::: "memory");
        }
    }
    __syncthreads();
}

struct Args { const float* in[25]; float* out; unsigned char* ws; int ph_lo, ph_hi; };
struct Frame {
    LAS unsigned char* lds; int tid, lane, wave, G, wg;
    const float *x, *p, *mix_norm_g, *w_in, *conv_w, *conv_b, *dt_bias, *a_log, *d_skip, *ssd_norm_g, *w_ssd_out, *pool_w, *pool_scale, *w_mix_out, *ffn_norm_g, *w_router, *b_router,
        *w_gate_up, *b_gate_up, *w_down, *b_down, *ple_norm_g, *w_ple_gate, *w_ple_proj, *final_norm_g;
    float* out;
    bf16 *WIN, *WOUT, *WPOOL, *WMIX, *WPG, *WPP, *WGU, *WDN;
    bf16 *XN, *PO, *YPG, *MIXED, *PB, *Z, *XBC, *U, *GT, *V, *ACT, *YR;
    float *DT, *SS, *RSTD, *TMP;
    bf16 *BN, *CN, *BT;
    int *TIDX, *DEST, *ROWTOK, *CNT, *PSTART, *TILE_E; float* TW;
};

struct GUnit { int pm, pn, e; const bf16* a; const bf16* bt; };
struct NoHook { static constexpr bool ON = false; __device__ __forceinline__ float ratio(int, int) const { return 1.f; } };
struct RstdHook { static constexpr bool ON = true; const float* rstd;
    __device__ __forceinline__ float ratio(int row, int g) const { return rstd[row * 4 + g]; } };

template <class Epi, class Hook>
__device__ __forceinline__ void sgemm_unit(const GUnit& u, int lda, int K, const int* gather, const Epi& E, const Hook& H, int wave, int lane) {
    const int wr = wave >> 2, wc = wave & 3, fr = lane & 15, fq = lane >> 4;
#pragma unroll 1
    for (int ai = 0; ai < 2; ++ai) {
        f32x4 acc[2][4][2];
#pragma unroll
        for (int bj = 0; bj < 2; ++bj)
#pragma unroll
            for (int m = 0; m < 4; ++m)
#pragma unroll
                for (int n = 0; n < 2; ++n) acc[bj][m][n] = (f32x4){0.f, 0.f, 0.f, 0.f};
        const bf16* ap[4]; const bf16* bp[2][2];
#pragma unroll
        for (int m = 0; m < 4; ++m) { const int row = u.pm * 256 + ai * 128 + wr * 64 + m * 16 + fr; const int src = gather ? gather[row] : row; ap[m] = u.a + (size_t)src * lda + 8 * fq; }
#pragma unroll
        for (int bj = 0; bj < 2; ++bj)
#pragma unroll
            for (int n = 0; n < 2; ++n) bp[bj][n] = u.bt + (size_t)(u.pn * 256 + bj * 128 + wc * 32 + perm32(n * 16 + fr)) * K + 8 * fq;
#pragma unroll 1
        for (int k0 = 0; k0 < K; k0 += 32) {
            bf16x8 af[4], bf[2][2];
#pragma unroll
            for (int m = 0; m < 4; ++m) af[m] = *(const bf16x8*)(ap[m] + k0);
#pragma unroll
            for (int bj = 0; bj < 2; ++bj)
#pragma unroll
                for (int n = 0; n < 2; ++n) bf[bj][n] = *(const bf16x8*)(bp[bj][n] + k0);
#pragma unroll
            for (int bj = 0; bj < 2; ++bj)
#pragma unroll
                for (int m = 0; m < 4; ++m)
#pragma unroll
                    for (int n = 0; n < 2; ++n) acc[bj][m][n] = __builtin_amdgcn_mfma_f32_16x16x32_bf16(bf[bj][n], af[m], acc[bj][m][n], 0, 0, 0);
            if (Hook::ON && ((k0 + 32) & 511) == 0) {
                const int g = (k0 + 32) / 512 - 1;
#pragma unroll
                for (int m = 0; m < 4; ++m) { const float r = H.ratio(u.pm * 256 + ai * 128 + wr * 64 + m * 16 + fr, g);
#pragma unroll
                    for (int bj = 0; bj < 2; ++bj)
#pragma unroll
                        for (int n = 0; n < 2; ++n) acc[bj][m][n] *= r; }
            }
        }
#pragma unroll
        for (int m = 0; m < 4; ++m) {
            const int row = u.pm * 256 + ai * 128 + wr * 64 + m * 16 + fr, colh = wc * 32 + 8 * fq;
            if constexpr (Epi::PAIR) E.pair(u, row, colh, acc[0][m][0], acc[0][m][1], acc[1][m][0], acc[1][m][1]);
            else { E(u, row, u.pn * 256 + colh, acc[0][m][0], acc[0][m][1]); E(u, row, u.pn * 256 + 128 + colh, acc[1][m][0], acc[1][m][1]); }
        }
    }
}


namespace pg {
constexpr int BK = 64, HALF = 128, HTB = HALF * BK * 2;
__host__ __device__ __forceinline__ int lds_byte(int r, int c) { const int st = (r >> 4) * 2 + (c >> 5), rr = r & 15, cc = c & 31, ob = rr * 64 + cc * 2; return st * 1024 + (ob ^ (((ob >> 9) & 1) << 5)); }
__host__ __device__ __forceinline__ void stage_rc(int b, int& R, int& C) { const int st = b / 1024, sb = b % 1024, swz = sb ^ (((sb >> 9) & 1) << 5); R = (st >> 1) * 16 + swz / 64; C = (st & 1) * 32 + (swz % 64) / 2; }

template <class Epi>
__device__ __forceinline__ void run_epi(const Epi& E, const f32x4 (&acc)[2][2][4][2], const GUnit& u, int wr, int wc, int fr, int fq) {
#pragma unroll
    for (int ai = 0; ai < 2; ++ai)
#pragma unroll
        for (int m = 0; m < 4; ++m) {
            const int row = u.pm * 256 + ai * 128 + wr * 64 + m * 16 + fr, colh = wc * 32 + 8 * fq;
            if constexpr (Epi::PAIR) E.pair(u, row, colh, acc[ai][0][m][0], acc[ai][0][m][1], acc[ai][1][m][0], acc[ai][1][m][1]);
            else { E(u, row, u.pn * 256 + colh, acc[ai][0][m][0], acc[ai][0][m][1]); E(u, row, u.pn * 256 + 128 + colh, acc[ai][1][m][0], acc[ai][1][m][1]); }
        }
}

template <class Epi, class Sched, class Hook, bool ALIGN_EPI, bool GATHER>
__device__ __forceinline__ void gemm_phase(LAS unsigned char* lds, const int lda, const int K, const int* gather, const Sched& S, const Epi& E, const Hook& H) {
    int tid = threadIdx.x; asm volatile("" : "+v"(tid));
    const int wid = __builtin_amdgcn_readfirstlane(tid >> 6), lane = tid & 63, wr = wid >> 2, wc = wid & 3, fr = lane & 15, fq = lane >> 4;
    const int nt = K / BK;
    unsigned voffA[2], voffB[2]; int R0, C0;
    { int R, C; stage_rc(tid * 16, R, C); R0 = R; C0 = C; }
#pragma unroll
    for (int i = 0; i < 2; ++i) { const int R = R0 + 64 * i; const int Rb = (R & ~31) + perm32(R & 31); voffA[i] = (unsigned)(R * lda + C0) * 2u; voffB[i] = (unsigned)(Rb * K + C0) * 2u; }
    const size_t kstep = (size_t)(BK * 2);
    const size_t hstepA = (size_t)HALF * lda * 2, hstepB = (size_t)HALF * K * 2;
    const unsigned ldsw = (unsigned)wid * 1024u;
    const int aoff = lds_byte(wr * 64 + fr, fq * 8), boff = lds_byte(wc * 32 + fr, fq * 8);
#define PG_SA(b, h) (((b) * 2 + (h)) * HTB)
#define PG_SB(b, h) ((4 + (b) * 2 + (h)) * HTB)
#define PG_GLDS(gp, bufoff, i) __builtin_amdgcn_global_load_lds((const unsigned*)(gp), (LAS unsigned*)(lds + (bufoff) + ldsw + (i) * 8192), 16, 0, 0)
#define PG_STAGE_B(bufoff, gbase) do { _Pragma("unroll") for (int _i = 0; _i < 2; ++_i) PG_GLDS((const char*)(gbase) + voffB[_i], bufoff, _i); } while (0)
#define PG_STAGE_A(bufoff, kp, h, NX) do { _Pragma("unroll") for (int _i = 0; _i < 2; ++_i) { \
        const char* _g = GATHER ? (const char*)(kp) + ((NX) ? nOff[h][_i] : cOff[h][_i]) : (const char*)(kp) + (size_t)(h) * hstepA + voffA[_i]; PG_GLDS(_g, bufoff, _i); } } while (0)
#define PG_LDA(dst, b, h) do { _Pragma("unroll") for (int m = 0; m < 4; ++m) _Pragma("unroll") for (int k = 0; k < 2; ++k) dst[m][k] = *(const LAS bf16x8*)(lds + PG_SA(b, h) + aoff + m * 2048 + k * 1024); } while (0)
#define PG_LDB(dst, b, h) do { _Pragma("unroll") for (int n = 0; n < 2; ++n) _Pragma("unroll") for (int k = 0; k < 2; ++k) dst[n][k] = *(const LAS bf16x8*)(lds + PG_SB(b, h) + boff + n * 2048 + k * 1024); } while (0)
#define PG_MMA(ai, bj, At, Bt) do { __builtin_amdgcn_s_setprio(1); _Pragma("unroll") for (int m = 0; m < 4; ++m) _Pragma("unroll") for (int n = 0; n < 2; ++n) _Pragma("unroll") for (int k = 0; k < 2; ++k) \
        acc[ai][bj][m][n] = __builtin_amdgcn_mfma_f32_16x16x32_bf16(Bt[n][k], At[m][k], acc[ai][bj][m][n], 0, 0, 0); __builtin_amdgcn_s_setprio(0); } while (0)
#define PG_WAIT_V(n) asm volatile("s_waitcnt vmcnt(" #n ")" ::: "memory")
#define PG_WAIT_L(n) asm volatile("s_waitcnt lgkmcnt(" #n ")" ::: "memory")
#define PG_BAR __builtin_amdgcn_s_barrier()
#define PG_SCHED __builtin_amdgcn_sched_barrier(0)
    GUnit cur, nxt; int ui = 0;
    if (!S.next(0, cur)) return;
    unsigned cOff[2][2] = {{0u, 0u}, {0u, 0u}}, nOff[2][2] = {{0u, 0u}, {0u, 0u}};
    if constexpr (GATHER) {
#pragma unroll
        for (int h = 0; h < 2; ++h)
#pragma unroll
            for (int i = 0; i < 2; ++i) cOff[h][i] = (unsigned)(gather[cur.pm * 256 + h * 128 + R0 + 64 * i] * lda + C0) * 2u;
    }
    f32x4 acc[2][2][4][2];
#pragma unroll
    for (int a = 0; a < 2; ++a)
#pragma unroll
        for (int b = 0; b < 2; ++b)
#pragma unroll
            for (int m = 0; m < 4; ++m)
#pragma unroll
                for (int n = 0; n < 2; ++n) acc[a][b][m][n] = (f32x4){0.f, 0.f, 0.f, 0.f};
    bf16x8 At[4][2], B0[2][2], B1[2][2];
    const char* cA = (const char*)cur.a + (GATHER ? (size_t)0 : (size_t)cur.pm * 2 * hstepA); const char* cB = (const char*)cur.bt + (size_t)cur.pn * 2 * hstepB;
    PG_STAGE_B(PG_SB(0, 0), cB); PG_STAGE_B(PG_SB(0, 1), cB + hstepB); PG_STAGE_A(PG_SA(0, 0), cA, 0, false); PG_STAGE_A(PG_SA(0, 1), cA, 1, false);
    if (wr == 1) PG_BAR;
    PG_WAIT_V(2); PG_BAR;
    PG_STAGE_B(PG_SB(1, 0), cB + kstep); PG_STAGE_A(PG_SA(1, 0), cA + kstep, 0, false); PG_STAGE_B(PG_SB(1, 1), cB + hstepB + kstep);
    PG_WAIT_V(6); PG_BAR;
    for (;;) {
        const bool has_next = S.next(ui + 1, nxt);
        const char* nA = has_next ? (const char*)nxt.a + (GATHER ? (size_t)0 : (size_t)nxt.pm * 2 * hstepA) : cA; const char* nB = has_next ? (const char*)nxt.bt + (size_t)nxt.pn * 2 * hstepB : cB;
        if constexpr (GATHER) {
            if (has_next) {
#pragma unroll
                for (int h = 0; h < 2; ++h)
#pragma unroll
                    for (int i = 0; i < 2; ++i) nOff[h][i] = (unsigned)(gather[nxt.pm * 256 + h * 128 + R0 + 64 * i] * lda + C0) * 2u;
            } else {
#pragma unroll
                for (int h = 0; h < 2; ++h)
#pragma unroll
                    for (int i = 0; i < 2; ++i) nOff[h][i] = cOff[h][i];
            }
        }
        for (int t = 0; t < nt; t += 2) {
            const bool last = (t == nt - 2);
            const char* a1 = cA + (size_t)(t + 1) * kstep;
            const char* a2 = last ? nA : cA + (size_t)(t + 2) * kstep; const char* b2 = last ? nB : cB + (size_t)(t + 2) * kstep;
            const char* a3 = a2 + kstep; const char* b3 = b2 + kstep;
            PG_LDB(B0, 0, 0); PG_LDB(B1, 0, 1); PG_SCHED; PG_LDA(At, 0, 0); PG_STAGE_A(PG_SA(1, 1), a1, 1, false);
            PG_WAIT_V(8); PG_WAIT_L(0); PG_BAR; PG_MMA(0, 0, At, B0); PG_MMA(0, 1, At, B1); PG_BAR; PG_SCHED;
            PG_LDA(At, 0, 1); PG_STAGE_B(PG_SB(0, 0), b2); PG_STAGE_B(PG_SB(0, 1), b2 + hstepB); PG_STAGE_A(PG_SA(0, 0), a2, 0, last);
            PG_WAIT_V(8); PG_WAIT_L(0); PG_BAR; PG_MMA(1, 0, At, B0); PG_MMA(1, 1, At, B1); PG_BAR; PG_SCHED;
            PG_LDB(B0, 1, 0); PG_LDB(B1, 1, 1); PG_SCHED; PG_LDA(At, 1, 0); PG_STAGE_A(PG_SA(0, 1), a2, 1, last);
            PG_WAIT_V(8); PG_WAIT_L(0); PG_BAR; PG_MMA(0, 0, At, B0); PG_MMA(0, 1, At, B1); PG_BAR; PG_SCHED;
            PG_LDA(At, 1, 1); PG_STAGE_B(PG_SB(1, 0), b3); PG_STAGE_B(PG_SB(1, 1), b3 + hstepB); PG_STAGE_A(PG_SA(1, 0), a3, 0, last);
            PG_WAIT_V(8); PG_WAIT_L(0); PG_BAR; PG_MMA(1, 0, At, B0); PG_MMA(1, 1, At, B1); PG_BAR; PG_SCHED;
            if constexpr (Hook::ON) { if (((t + 2) & 7) == 0) H.apply(acc, (t + 2) / 8 - 1, wr, fr); }
        }
        if constexpr (ALIGN_EPI) { if (wr == 0) PG_BAR; }
        run_epi(E, acc, cur, wr, wc, fr, fq);
        if (!has_next) break;
#pragma unroll
        for (int a = 0; a < 2; ++a)
#pragma unroll
            for (int b = 0; b < 2; ++b)
#pragma unroll
                for (int m = 0; m < 4; ++m)
#pragma unroll
                    for (int n = 0; n < 2; ++n) acc[a][b][m][n] = (f32x4){0.f, 0.f, 0.f, 0.f};
        cur = nxt; cA = nA; cB = nB; ++ui;
        if constexpr (GATHER) {
#pragma unroll
            for (int h = 0; h < 2; ++h)
#pragma unroll
                for (int i = 0; i < 2; ++i) cOff[h][i] = nOff[h][i];
        }
        if constexpr (ALIGN_EPI) { if (wr == 1) PG_BAR; }
    }
    PG_WAIT_V(0);
    if constexpr (!ALIGN_EPI) { if (wr == 0) PG_BAR; }
    PG_BAR;
#undef PG_SA
#undef PG_SB
#undef PG_GLDS
#undef PG_STAGE_A
#undef PG_STAGE_B
#undef PG_LDA
#undef PG_LDB
#undef PG_MMA
#undef PG_WAIT_V
#undef PG_WAIT_L
#undef PG_BAR
#undef PG_SCHED
}
}

struct DenseOrder {
    int nM, nN, nwg, G, c; const bf16* a; const bf16* bt;
    __device__ __forceinline__ bool next(int i, GUnit& u) const {
        const int L = i * G + c; if (L >= nwg) return false;
        int wgid = L; { const int q = nwg / 8, r = nwg % 8, xcd = wgid % 8, off = wgid / 8; wgid = (xcd < r ? xcd * (q + 1) : r * (q + 1) + (xcd - r) * q) + off; }
        const int nig = 8 * nN, gid = wgid / nig, fm = gid * 8, gsz = (nM - fm) < 8 ? (nM - fm) : 8;
        u.pm = fm + ((wgid % nig) % gsz); u.pn = (wgid % nig) / gsz; u.e = 0; u.a = a; u.bt = bt; return true;
    } };
struct PoolOrder { int G, c; const bf16* PO; const bf16* WPOOL;
    __device__ __forceinline__ bool next(int i, GUnit& u) const { const int L = i * G + c; if (L >= 256) return false; u.pm = L >> 2; u.pn = 0; u.e = L & 3; u.a = PO + 256 * u.e; u.bt = WPOOL + (size_t)u.e * 65536; return true; } };
template <int NCOL, int BROWS> struct MoeOrder { int G, c, nrt; const int* tile_e; const bf16* a; const bf16* w;
    __device__ __forceinline__ bool next(int i, GUnit& u) const { const int L = i * G + c; if (L >= nrt * NCOL) return false; u.pm = L / NCOL; u.pn = L % NCOL; u.e = tile_e[u.pm]; u.a = a; u.bt = w + (size_t)u.e * BROWS * 1024; return true; } };
struct NoHookPg { static constexpr bool ON = false; __device__ __forceinline__ void apply(f32x4 (&)[2][2][4][2], int, int, int) const {} };
struct RatioHook { static constexpr bool ON = true; const LAS float* tab;
    __device__ __forceinline__ void apply(f32x4 (&acc)[2][2][4][2], int g, int wr, int fr) const {
#pragma unroll
        for (int ai = 0; ai < 2; ++ai)
#pragma unroll
            for (int m = 0; m < 4; ++m) { const float r = tab[(ai * 128 + wr * 64 + m * 16 + fr) * 4 + g];
#pragma unroll
                for (int bj = 0; bj < 2; ++bj)
#pragma unroll
                    for (int n = 0; n < 2; ++n) acc[ai][bj][m][n] *= r; }
    } };

struct EpiInproj { static constexpr bool PAIR = false; bf16 *Z, *XBC, *U, *GT;
    __device__ __forceinline__ void operator()(const GUnit&, int row, int col, f32x4 lo, f32x4 hi) const {
        if (col < 2048) { for (int i = 0; i < 4; ++i) { lo[i] = siluf_(lo[i]); hi[i] = siluf_(hi[i]); } *(u32x4*)(Z + (size_t)row * 2048 + col) = pack8(lo, hi); }
        else if (col < 5120) *(u32x4*)(XBC + (size_t)row * 3072 + (col - 2048)) = pack8(lo, hi);
        else if (col < 6144) *(u32x4*)(U + (size_t)row * 1024 + (col - 5120)) = pack8(lo, hi);
        else { for (int i = 0; i < 4; ++i) { lo[i] = sigmoidf_(lo[i]); hi[i] = sigmoidf_(hi[i]); } *(u32x4*)(GT + (size_t)row * 2048 + (col - 6144)) = pack8(lo, hi); }
    } };
struct EpiPool { static constexpr bool PAIR = false; bf16* YPG; const bf16* GT;
    __device__ __forceinline__ void operator()(const GUnit& u, int row, int col, f32x4 lo, f32x4 hi) const {
        const int c = u.e * 256 + col; float g[8]; unpack8(*(const u32x4*)(GT + (size_t)row * 2048 + 1024 + c), g);
        for (int i = 0; i < 4; ++i) { lo[i] *= g[i]; hi[i] *= g[4 + i]; }
        *(u32x4*)(YPG + (size_t)row * 1024 + c) = pack8(lo, hi);
    } };
struct EpiOut { static constexpr bool PAIR = false; bf16* MIXED; const bf16 *GT, *YPG;
    __device__ __forceinline__ void operator()(const GUnit&, int row, int col, f32x4 lo, f32x4 hi) const {
        float g[8], y[8]; unpack8(*(const u32x4*)(GT + (size_t)row * 2048 + col), g); unpack8(*(const u32x4*)(YPG + (size_t)row * 1024 + col), y);
        for (int i = 0; i < 4; ++i) { lo[i] = lo[i] * g[i] + y[i]; hi[i] = hi[i] * g[4 + i] + y[4 + i]; }
        *(u32x4*)(MIXED + (size_t)row * 1024 + col) = pack8(lo, hi);
    } };
struct EpiMix { static constexpr bool PAIR = false; const float* x; float* X1;
    __device__ __forceinline__ void operator()(const GUnit&, int row, int col, f32x4 lo, f32x4 hi) const {
        const f32x4 a = *(const f32x4*)(x + (size_t)row * 1024 + col), b = *(const f32x4*)(x + (size_t)row * 1024 + col + 4);
        *(f32x4*)(X1 + (size_t)row * 1024 + col) = a + lo; *(f32x4*)(X1 + (size_t)row * 1024 + col + 4) = b + hi;
    } };
struct EpiGU { static constexpr bool PAIR = true; bf16* ACT; const float* b_gate_up;
    __device__ __forceinline__ void pair(const GUnit& u, int row, int colh, f32x4 g0, f32x4 g1, f32x4 u0, f32x4 u1) const {
        const int c = u.pn * 128 + colh; const float* bg = b_gate_up + (size_t)u.e * 2048 + c;
        const f32x4 bg0 = *(const f32x4*)bg, bg1 = *(const f32x4*)(bg + 4), bu0 = *(const f32x4*)(bg + 1024), bu1 = *(const f32x4*)(bg + 1028);
        f32x4 lo, hi;
        for (int i = 0; i < 4; ++i) {
            float ga = fminf(g0[i] + bg0[i], 7.f), up = fminf(fmaxf(u0[i] + bu0[i], -7.f), 7.f); lo[i] = (up + 1.f) * ga * sigmoidf_(1.702f * ga);
            ga = fminf(g1[i] + bg1[i], 7.f); up = fminf(fmaxf(u1[i] + bu1[i], -7.f), 7.f); hi[i] = (up + 1.f) * ga * sigmoidf_(1.702f * ga); }
        *(u32x4*)(ACT + (size_t)row * 1024 + c) = pack8(lo, hi);
    } };
struct EpiDN { static constexpr bool PAIR = false; bf16* YR; const float* b_down;
    __device__ __forceinline__ void operator()(const GUnit& u, int row, int col, f32x4 lo, f32x4 hi) const {
        const float* b = b_down + (size_t)u.e * 1024 + col; lo += *(const f32x4*)b; hi += *(const f32x4*)(b + 4);
        *(u32x4*)(YR + (size_t)row * 1024 + col) = pack8(lo, hi);
    } };
struct EpiF32 { static constexpr bool PAIR = false; float* C;
    __device__ __forceinline__ void operator()(const GUnit&, int row, int col, f32x4 lo, f32x4 hi) const { *(f32x4*)(C + (size_t)row * 1024 + col) = lo; *(f32x4*)(C + (size_t)row * 1024 + col + 4) = hi; } };
struct EpiPle { static constexpr bool PAIR = false; const float* TMP; float* X;
    __device__ __forceinline__ void operator()(const GUnit&, int row, int col, f32x4 lo, f32x4 hi) const {
        float* xp = X + (size_t)row * 1024 + col; const float* tp = TMP + (size_t)row * 1024 + col;
        const f32x4 t0 = *(const f32x4*)tp, t1 = *(const f32x4*)(tp + 4); f32x4 x0 = *(const f32x4*)xp, x1 = *(const f32x4*)(xp + 4);
        for (int i = 0; i < 4; ++i) { x0[i] += sigmoidf_(lo[i]) * t0[i]; x1[i] += sigmoidf_(hi[i]) * t1[i]; }
        *(f32x4*)xp = x0; *(f32x4*)(xp + 4) = x1;
    } };

__device__ __forceinline__ void tr_item(const float* W, int ldw, int n0src, int k0, bf16* WT, int K, int dstrow0, const float* kscale, const float* nscale, LAS float* scr, int lane) {
    const int kk0 = lane >> 4, nn = 4 * (lane & 15);
    f32x4 v[16];
#pragma unroll
    for (int i = 0; i < 16; ++i) v[i] = *(const f32x4*)(W + (size_t)(k0 + 4 * i + kk0) * ldw + n0src + nn);
    if (nscale) { const f32x4 ns = *(const f32x4*)(nscale + n0src + nn);
#pragma unroll
        for (int i = 0; i < 16; ++i) v[i] *= ns; }
    if (kscale) {
#pragma unroll
        for (int i = 0; i < 16; ++i) v[i] *= kscale[k0 + 4 * i + kk0]; }
#pragma unroll
    for (int i = 0; i < 16; ++i) { LAS float* d = scr + (4 * i + kk0) * 65 + nn; d[0] = v[i][0]; d[1] = v[i][1]; d[2] = v[i][2]; d[3] = v[i][3]; }
    asm volatile("s_waitcnt lgkmcnt(0)" ::: "memory");
    const int c = lane & 7;
#pragma unroll
    for (int j = 0; j < 8; ++j) { const int n = (lane >> 3) + 8 * j; const LAS float* sp = scr + (8 * c) * 65 + n;
        u32x4 o; o.x = pk2(sp[0 * 65], sp[1 * 65]); o.y = pk2(sp[2 * 65], sp[3 * 65]); o.z = pk2(sp[4 * 65], sp[5 * 65]); o.w = pk2(sp[6 * 65], sp[7 * 65]);
        *(u32x4*)(WT + (size_t)(dstrow0 + n) * K + k0 + 8 * c) = o; }
    asm volatile("s_waitcnt lgkmcnt(0)" ::: "memory");
}
constexpr int O_W32 = 0, O_W32_SCR = 131072 + 8192, O_W32_CNT = 131072 + 4096;
__device__ __forceinline__ void w32_fill(const Frame& F, const float* src, int ld) {
#pragma unroll 4
    for (int i = 0; i < 16; ++i) { const int idx = F.tid + NTHREADS * i, k = idx >> 3, cq = idx & 7;
        *(LAS f32x4*)(F.lds + O_W32 + k * 128 + ((cq ^ ((k >> 1) & 7)) << 4)) = *(const f32x4*)(src + (size_t)k * ld + cq * 4); }
}
__device__ __forceinline__ void w32_dot2(const LAS unsigned char* lds, const float (&xa)[16], const float (&xb)[16], int lane, float& ra, float& rb) {
    float la[32], lb[32];
#pragma unroll
    for (int e = 0; e < 32; ++e) { la[e] = 0.f; lb[e] = 0.f; }
    const int sw = (lane >> 1) & 7;
#pragma unroll
    for (int q = 0; q < 16; ++q) { const LAS unsigned char* rowp = lds + O_W32 + (lane + 64 * q) * 128;
#pragma unroll
        for (int cq = 0; cq < 8; ++cq) { const f32x4 w = *(const LAS f32x4*)(rowp + ((cq ^ sw) << 4));
#pragma unroll
            for (int i = 0; i < 4; ++i) { la[4 * cq + i] = fmaf(xa[q], w[i], la[4 * cq + i]); lb[4 * cq + i] = fmaf(xb[q], w[i], lb[4 * cq + i]); } }
        __builtin_amdgcn_sched_barrier(0); }
#define W32_STAGE(HALF, BIT) { const bool up = (lane & (BIT)) != 0; _Pragma("unroll") for (int i = 0; i < (HALF); ++i) { \
        const float sa = up ? la[i] : la[i + (HALF)], ka = up ? la[i + (HALF)] : la[i]; la[i] = ka + __shfl_xor(sa, (BIT)); \
        const float sb = up ? lb[i] : lb[i + (HALF)], kb = up ? lb[i + (HALF)] : lb[i]; lb[i] = kb + __shfl_xor(sb, (BIT)); } }
    W32_STAGE(16, 32) W32_STAGE(8, 16) W32_STAGE(4, 8) W32_STAGE(2, 4) W32_STAGE(1, 2)
#undef W32_STAGE
    ra = la[0] + __shfl_xor(la[0], 1); rb = lb[0] + __shfl_xor(lb[0], 1);
}
__device__ __forceinline__ int w32_col(int lane) { return ((lane >> 5) & 1) * 16 + ((lane >> 4) & 1) * 8 + ((lane >> 3) & 1) * 4 + ((lane >> 2) & 1) * 2 + ((lane >> 1) & 1); }

template <class Out>
__device__ __forceinline__ void w32_rows(const Frame& F, const float* X, const float* gain, bf16* XNout, const Out& O) {
    const int lane = F.lane;
    float gq[16];
#pragma unroll
    for (int q = 0; q < 16; ++q) gq[q] = gain[lane + 64 * q];
    const int row0 = F.wg * 64 + F.wave * 8;
    float cd[2][16];
#pragma unroll
    for (int r = 0; r < 2; ++r)
#pragma unroll
        for (int q = 0; q < 16; ++q) cd[r][q] = X[(size_t)(row0 + r) * D + lane + 64 * q];
#pragma unroll 1
    for (int it = 0; it < 4; ++it) {
        float nd[2][16];
        const int nrow = row0 + 2 * (it < 3 ? it + 1 : it);
#pragma unroll
        for (int r = 0; r < 2; ++r)
#pragma unroll
            for (int q = 0; q < 16; ++q) nd[r][q] = X[(size_t)(nrow + r) * D + lane + 64 * q];
#pragma unroll
        for (int r = 0; r < 2; ++r) { float sq = 0.f;
#pragma unroll
            for (int q = 0; q < 16; ++q) sq = fmaf(cd[r][q], cd[r][q], sq);
            const float rs = rsqrtf(wave_sum(sq) * (1.f / D) + EPS);
            bf16* op = XNout + (size_t)(row0 + 2 * it + r) * D + lane;
#pragma unroll
            for (int q = 0; q < 16; ++q) { cd[r][q] = cd[r][q] * rs * gq[q]; op[64 * q] = (bf16)f2bf(cd[r][q]); } }
        float ra, rb; w32_dot2(F.lds, cd[0], cd[1], lane, ra, rb);
        O.emit(row0 + 2 * it, ra, lane); O.emit(row0 + 2 * it + 1, rb, lane);
#pragma unroll
        for (int r = 0; r < 2; ++r)
#pragma unroll
            for (int q = 0; q < 16; ++q) cd[r][q] = nd[r][q];
    }
}
struct DtOut { float* DT; const float* dt_bias;
    __device__ __forceinline__ void emit(int row, float dot, int lane) const { if ((lane & 1) == 0) { const int e = w32_col(lane); const float dtr = dot + dt_bias[e]; DT[(size_t)row * 32 + e] = dtr > 20.f ? dtr : log1pf(__expf(dtr)); } } };
struct RouterOut { LAS float* lscr; LAS int* cnt; const float* b_router; int* TIDX; float* TW;
    __device__ __forceinline__ void emit(int row, float dot, int lane) const {
        if ((lane & 1) == 0) { const int e = w32_col(lane); lscr[e] = dot + b_router[e]; }
        asm volatile("s_waitcnt lgkmcnt(0)" ::: "memory");
        float lg[32];
#pragma unroll
        for (int q = 0; q < 8; ++q) { const f32x4 t4 = *(const LAS f32x4*)(lscr + 4 * q); lg[4 * q] = t4[0]; lg[4 * q + 1] = t4[1]; lg[4 * q + 2] = t4[2]; lg[4 * q + 3] = t4[3]; }
        asm volatile("s_waitcnt lgkmcnt(0)" ::: "memory");
        float tv[4]; int ti[4];
#pragma unroll
        for (int k = 0; k < 4; ++k) { float best = -INFINITY; int bi = 0;
#pragma unroll
            for (int e = 0; e < 32; ++e) if (lg[e] > best) { best = lg[e]; bi = e; }
            tv[k] = best; ti[k] = bi;
#pragma unroll
            for (int e = 0; e < 32; ++e) if (e == bi) lg[e] = -INFINITY; }
        float ex[4], se = 0.f;
#pragma unroll
        for (int k = 0; k < 4; ++k) { ex[k] = __expf(tv[k] - tv[0]); se += ex[k]; }
        if (lane == 0) {
#pragma unroll
            for (int k = 0; k < 4; ++k) { TIDX[row * 4 + k] = ti[k]; TW[row * 4 + k] = ex[k] / se; __hip_atomic_fetch_add(cnt + ti[k], 1, __ATOMIC_RELAXED, __HIP_MEMORY_SCOPE_WORKGROUP); } }
    } };

__device__ __forceinline__ void p0_prologue(const Frame& F) {
    LAS float* scr = (LAS float*)(F.lds + F.wave * 16640);
    const int gw = F.wg * NWAVES + F.wave, NGW = F.G * NWAVES, lane = F.lane;
    constexpr int I_WIN = 16 * 128, I_WOUT = 32 * 16, I_WPOOL = 4 * 4 * 4, I_WMIX = 16 * 16, I_WPG = 16 * 16, I_WPP = 4 * 16, I_WGU = 32 * 16 * 32, I_WDN = 32 * 16 * 16;
    constexpr int NITEMS = I_WIN + I_WOUT + I_WPOOL + I_WMIX + I_WPG + I_WPP + I_WGU + I_WDN;
#pragma unroll 1
    for (int it = gw; it < NITEMS * (REP_SUB == 1 ? 2 : 1); it += NGW) {
        int r = it >= NITEMS ? it - NITEMS : it;
        if (r < I_WIN) { const int kb = r >> 7, nb = r & 127; const int dst = 64 * nb, src = dst + (dst >= 5120 ? 32 : 0); tr_item(F.w_in, NPROJ, src, 64 * kb, F.WIN, 1024, dst, nullptr, nullptr, scr, lane); continue; } r -= I_WIN;
        if (r < I_WOUT) { const int kb = r >> 4, nb = r & 15; tr_item(F.w_ssd_out, 1024, 64 * nb, 64 * kb, F.WOUT, 2048, 64 * nb, F.ssd_norm_g, nullptr, scr, lane); continue; } r -= I_WOUT;
        if (r < I_WPOOL) { const int g = r >> 4, q = r & 15, kb = q >> 2, nb = q & 3; tr_item(F.pool_w + (size_t)g * 65536, 256, 64 * nb, 64 * kb, F.WPOOL + (size_t)g * 65536, 256, 64 * nb, nullptr, F.pool_scale + g * 256, scr, lane); continue; } r -= I_WPOOL;
        if (r < I_WMIX) { const int kb = r >> 4, nb = r & 15; tr_item(F.w_mix_out, 1024, 64 * nb, 64 * kb, F.WMIX, 1024, 64 * nb, nullptr, nullptr, scr, lane); continue; } r -= I_WMIX;
        if (r < I_WPG) { const int kb = r >> 4, nb = r & 15; tr_item(F.w_ple_gate, 1024, 64 * nb, 64 * kb, F.WPG, 1024, 64 * nb, nullptr, nullptr, scr, lane); continue; } r -= I_WPG;
        if (r < I_WPP) { const int kb = r >> 4, nb = r & 15; tr_item(F.w_ple_proj, 1024, 64 * nb, 64 * kb, F.WPP, 256, 64 * nb, nullptr, nullptr, scr, lane); continue; } r -= I_WPP;
        if (r < I_WGU) { const int e = r >> 9, q = r & 511, kb = q >> 5, nb = q & 31; const int c = 64 * nb, sx = c >> 10, rr = c & 1023, dst = 256 * (rr >> 7) + 128 * sx + (rr & 127);
            tr_item(F.w_gate_up + (size_t)e * 1024 * 2048, 2048, c, 64 * kb, F.WGU + (size_t)e * 2048 * 1024, 1024, dst, nullptr, nullptr, scr, lane); continue; } r -= I_WGU;
        { const int e = r >> 8, q = r & 255, kb = q >> 4, nb = q & 15; tr_item(F.w_down + (size_t)e * 1024 * 1024, 1024, 64 * nb, 64 * kb, F.WDN + (size_t)e * 1024 * 1024, 1024, 64 * nb, nullptr, nullptr, scr, lane); }
    }
    const size_t n8 = (size_t)T * DPLE / 8;
#pragma unroll 1
    for (size_t i = (size_t)F.wg * NTHREADS + F.tid; i < n8; i += (size_t)F.G * NTHREADS) { const f32x4 a = ((const f32x4*)F.p)[2 * i], b = ((const f32x4*)F.p)[2 * i + 1]; ((u32x4*)F.PB)[i] = pack8(a, b); }
}
__device__ __forceinline__ void p0_rows(const Frame& F) {
    __syncthreads();
    w32_fill(F, F.w_in + 5120, NPROJ);
    __syncthreads();
    const DtOut O{F.DT, F.dt_bias};
#pragma unroll 1
    for (int rep = 0; rep < (REP_SUB == 2 ? 2 : 1); ++rep) w32_rows(F, F.x, F.mix_norm_g, F.XN, O);
}

template <class Epi, class Hook>
__device__ __forceinline__ void dense_gemm_phase(const Frame& F, const bf16* A, int lda, const bf16* Bt, int K, int nM, int nN, const Epi& E, const Hook& H) {
#pragma unroll 1
    for (int ui = F.wg; ui < nM * nN; ui += F.G) { GUnit u; u.pm = ui / nN; u.pn = ui % nN; u.e = 0; u.a = A; u.bt = Bt; sgemm_unit(u, lda, K, nullptr, E, H, F.wave, F.lane); }
}

__device__ __forceinline__ void p2_pool(const Frame& F) {
    const int item = F.wg * NTHREADS + F.tid, cb = item & 127, run = item >> 7, c = cb * 8, w = 2 << (cb >> 5), t_s = run * 16, pos0 = t_s & (SEQ - 1);
    float S[8];
#pragma unroll
    for (int q = 0; q < 8; ++q) S[q] = 0.f;
    const int npre = pos0 < w - 1 ? pos0 : w - 1;
#pragma unroll 1
    for (int j = 1; j <= npre; ++j) { float f[8]; unpack8(*(const u32x4*)(F.U + (size_t)(t_s - j) * 1024 + c), f);
#pragma unroll
        for (int q = 0; q < 8; ++q) S[q] += f[q]; }
#pragma unroll 2
    for (int j = 0; j < 16; ++j) { const int t = t_s + j, pos = pos0 + j; float u0[8]; unpack8(*(const u32x4*)(F.U + (size_t)t * 1024 + c), u0);
        const int cnt = pos + 1 < w ? pos + 1 : w; const float inv = 1.f / (float)cnt; f32x4 lo, hi;
#pragma unroll
        for (int q = 0; q < 8; ++q) { S[q] += u0[q]; const float o = S[q] * inv - u0[q]; if (q < 4) lo[q] = o; else hi[q - 4] = o; }
        *(u32x4*)(F.PO + (size_t)t * 1024 + c) = pack8(lo, hi);
        if (pos + 1 >= w) { float f[8]; unpack8(*(const u32x4*)(F.U + (size_t)(t - w + 1) * 1024 + c), f);
#pragma unroll
            for (int q = 0; q < 8; ++q) S[q] -= f[q]; } }
}
__device__ __forceinline__ void p2_ssd_naive(const Frame& F) {
    LAS float* sx = (LAS float*)F.lds; LAS float* sB = sx + 128; LAS float* sC = sB + 256; LAS float* sq = sC + 256;
    const int tid = F.tid;
#pragma unroll 1
    for (int unit = F.wg; unit < NB * NH; unit += F.G) {
        const int b = unit / NH, h = unit % NH, g = h / 8, p = tid >> 3, nb = tid & 7;
        int cch = -1;
        if (tid < 64) cch = h * 64 + tid; else if (tid < 192) cch = 2048 + g * 128 + (tid - 64); else if (tid < 320) cch = 2560 + g * 128 + (tid - 192);
        float w0 = 0, w1 = 0, w2 = 0, w3 = 0, cb = 0;
        if (cch >= 0) { w0 = F.conv_w[cch]; w1 = F.conv_w[DCONV + cch]; w2 = F.conv_w[2 * DCONV + cch]; w3 = F.conv_w[3 * DCONV + cch]; cb = F.conv_b[cch]; }
        const float a = -__expf(F.a_log[h]), dsk = F.d_skip[h];
        float st[16];
#pragma unroll
        for (int i = 0; i < 16; ++i) st[i] = 0.f;
        float x1 = 0.f, x2 = 0.f, x3 = 0.f;
        __syncthreads();
#pragma unroll 1
        for (int t = 0; t < SEQ; ++t) {
            const size_t row = (size_t)(b * SEQ + t); const int buf = t & 1;
            if (cch >= 0) {
                const float x0 = bf2f(F.XBC[row * DCONV + cch]);
                float v = cb + w3 * x0 + w2 * x1 + w1 * x2 + w0 * x3; x3 = x2; x2 = x1; x1 = x0; v = siluf_(v);
                if (tid < 64) sx[buf * 64 + tid] = v; else if (tid < 192) sB[buf * 128 + tid - 64] = v; else sC[buf * 128 + tid - 192] = v;
            }
            const float dt = F.DT[row * 32 + h], dA = __expf(dt * a);
            __syncthreads();
            const float xv = sx[buf * 64 + p], dx = dt * xv; float y = 0.f;
#pragma unroll
            for (int i = 0; i < 16; ++i) { st[i] = st[i] * dA + dx * sB[buf * 128 + nb * 16 + i]; y = fmaf(sC[buf * 128 + nb * 16 + i], st[i], y); }
            y += __shfl_xor(y, 1); y += __shfl_xor(y, 2); y += __shfl_xor(y, 4);
            if (nb == 0) { const float v = (y + dsk * xv) * bf2f(F.Z[row * DIN + h * 64 + p]); F.V[row * DIN + h * 64 + p] = (bf16)f2bf(v); sq[p] = v * v; }
            __syncthreads();
            if (tid < 64) { const float ssum = wave_sum(sq[tid]); if (tid == 0) F.SS[row * 32 + h] = ssum; }
        }
        __syncthreads();
    }
}
__device__ __forceinline__ void p2a_conv_bc(const Frame& F) {
    {
        const int item = F.wg * NTHREADS + F.tid, cb = item & 127, run = item >> 7, ch0 = 2048 + cb * 8, t_start = run * 16;
        float w[4][8], bias[8];
#pragma unroll
        for (int k = 0; k < 4; ++k) { const f32x4 a = *(const f32x4*)(F.conv_w + k * DCONV + ch0), b = *(const f32x4*)(F.conv_w + k * DCONV + ch0 + 4);
#pragma unroll
            for (int i = 0; i < 4; ++i) { w[k][i] = a[i]; w[k][4 + i] = b[i]; } }
        { const f32x4 a = *(const f32x4*)(F.conv_b + ch0), b = *(const f32x4*)(F.conv_b + ch0 + 4);
#pragma unroll
            for (int i = 0; i < 4; ++i) { bias[i] = a[i]; bias[4 + i] = b[i]; } }
        float r1[8], r2[8], r3[8];
        if ((t_start & (SEQ - 1)) == 0) {
#pragma unroll
            for (int i = 0; i < 8; ++i) { r1[i] = 0.f; r2[i] = 0.f; r3[i] = 0.f; }
        } else { unpack8(*(const u32x4*)(F.XBC + (size_t)(t_start - 1) * DCONV + ch0), r1); unpack8(*(const u32x4*)(F.XBC + (size_t)(t_start - 2) * DCONV + ch0), r2); unpack8(*(const u32x4*)(F.XBC + (size_t)(t_start - 3) * DCONV + ch0), r3); }
        bf16* dst = (cb < 64 ? F.BN + (size_t)(cb >> 4) * T * 128 + (cb & 15) * 8 : F.CN + (size_t)((cb - 64) >> 4) * T * 128 + ((cb - 64) & 15) * 8);
#pragma unroll 2
        for (int j = 0; j < 16; ++j) { const int t = t_start + j; float x0[8]; unpack8(*(const u32x4*)(F.XBC + (size_t)t * DCONV + ch0), x0);
            f32x4 lo, hi;
#pragma unroll
            for (int i = 0; i < 8; ++i) { const float v = siluf_(bias[i] + w[3][i] * x0[i] + w[2][i] * r1[i] + w[1][i] * r2[i] + w[0][i] * r3[i]); if (i < 4) lo[i] = v; else hi[i - 4] = v; r3[i] = r2[i]; r2[i] = r1[i]; r1[i] = x0[i]; }
            *(u32x4*)(dst + (size_t)t * 128) = pack8(lo, hi); }
    }
    {
        const int b = F.wg >> 5, g = (F.wg >> 3) & 3, cc = 4 * (F.wg & 7) + (F.tid >> 7), n = F.tid & 127, ch = 2048 + g * 128 + n, t0 = b * SEQ + cc * 64;
        const float w0 = F.conv_w[ch], w1 = F.conv_w[DCONV + ch], w2 = F.conv_w[2 * DCONV + ch], w3 = F.conv_w[3 * DCONV + ch], cbias = F.conv_b[ch];
        float x1 = 0.f, x2 = 0.f, x3 = 0.f;
        if (cc != 0) { x1 = bf2f(F.XBC[(size_t)(t0 - 1) * DCONV + ch]); x2 = bf2f(F.XBC[(size_t)(t0 - 2) * DCONV + ch]); x3 = bf2f(F.XBC[(size_t)(t0 - 3) * DCONV + ch]); }
        bf16* dst = F.BT + ((size_t)((b * 32 + cc) * 4 + g) * 128 + n) * 64;
#pragma unroll 1
        for (int blk = 0; blk < 8; ++blk) { float v[8];
#pragma unroll
            for (int i = 0; i < 8; ++i) { const float x0 = bf2f(F.XBC[(size_t)(t0 + blk * 8 + i) * DCONV + ch]); v[i] = siluf_(cbias + w3 * x0 + w2 * x1 + w1 * x2 + w0 * x3); x3 = x2; x2 = x1; x1 = x0; }
            *(u32x4*)(dst + blk * 8) = pack8((f32x4){v[0], v[1], v[2], v[3]}, (f32x4){v[4], v[5], v[6], v[7]}); }
    }
}

namespace ssd {
constexpr int BUFSZ = 58368, O_BN = 0, O_CN = 16384, O_BT = 32768, O_RAW = 49152;
constexpr int O_XT = 116736, O_XWT = 124928, O_MM = 133120, O_HB = 141312, O_DT = 157696, O_A2 = 157952, O_SSP = 158208;
__device__ __forceinline__ bf16x8 frag256(const LAS unsigned char* tile, int row, int c) { return *(const LAS bf16x8*)(tile + row * 256 + ((c ^ (row & 15)) << 4)); }
__device__ __forceinline__ bf16x8 frag128(const LAS unsigned char* tile, int row, int c) { return *(const LAS bf16x8*)(tile + row * 128 + ((c ^ ((row >> 1) & 7)) << 4)); }
#define SSD_BAR() do { asm volatile("s_waitcnt lgkmcnt(0)" ::: "memory"); __builtin_amdgcn_s_barrier(); asm volatile("" ::: "memory"); } while (0)
#define SSD_GLDS(gp, ldsoff) __builtin_amdgcn_global_load_lds((const unsigned*)(gp), (LAS unsigned*)(lds + (ldsoff)), 16, 0, 0)
}
__device__ __forceinline__ void ssd_issue(LAS unsigned char* lds, const bf16* BNg, const bf16* CNg, const bf16* BT, const bf16* XBC, int b, int g, int h, int c, int w, int lane) {
    using namespace ssd;
    const int t0 = b * SEQ + c * 64; const int bo = (c & 1) * BUFSZ;
#pragma unroll
    for (int jj = 0; jj < 2; ++jj) { const int j = 2 * w + jj;
        { const int row = 4 * j + (lane >> 4), ck = (lane & 15) ^ (row & 15);
          SSD_GLDS(BNg + (size_t)(t0 + row) * 128 + ck * 8, bo + O_BN + j * 1024); SSD_GLDS(CNg + (size_t)(t0 + row) * 128 + ck * 8, bo + O_CN + j * 1024); }
        { const int row = 8 * j + (lane >> 3), ck = (lane & 7) ^ ((row >> 1) & 7);
          SSD_GLDS(BT + ((size_t)((b * 32 + c) * 4 + g) * 128 + row) * 64 + ck * 8, bo + O_BT + j * 1024); } }
    { const int row = 8 * w + (lane >> 3); SSD_GLDS(XBC + (size_t)(t0 - 3 + row) * DCONV + h * 64 + (lane & 7) * 8, bo + O_RAW + w * 1024); }
    if (w == 0) { const int row = 64 + (lane >> 3); SSD_GLDS(XBC + (size_t)(t0 - 3 + row) * DCONV + h * 64 + (lane & 7) * 8, bo + O_RAW + 8 * 1024); }
}
__device__ __forceinline__ void p2b_ssd(const Frame& F) {
    using namespace ssd;
    LAS unsigned char* lds = F.lds;
    const int lane = F.lane, w = F.wave, fr = lane & 15, fq = lane >> 4;
    const int xs = F.wg & 7, wi = F.wg >> 3, gi = (wi >> 3) + 4 * xs, b = gi >> 2, g = gi & 3, h = g * 8 + (wi & 7);
    const float a_l2 = -__expf(F.a_log[h]) * 1.44269504f, dsk = F.d_skip[h];
    const int chx = h * 64 + lane;
    const float cw0 = F.conv_w[chx], cw1 = F.conv_w[DCONV + chx], cw2 = F.conv_w[2 * DCONV + chx], cw3 = F.conv_w[3 * DCONV + chx], cbias = F.conv_b[chx];
    const bf16* BNg = F.BN + (size_t)g * T * 128; const bf16* CNg = F.CN + (size_t)g * T * 128;
    f32x4 hacc[4];
#pragma unroll
    for (int i = 0; i < 4; ++i) hacc[i] = (f32x4){0.f, 0.f, 0.f, 0.f};
    ssd_issue(lds, BNg, CNg, F.BT, F.XBC, b, g, h, 0, w, lane);
    float dt_next = (w == 0) ? F.DT[(size_t)(b * SEQ + lane) * 32 + h] : 0.f;
#pragma unroll 1
    for (int c = 0; c < 32; ++c) {
        const int t0 = b * SEQ + c * 64; const LAS unsigned char* ib = lds + (c & 1) * BUFSZ;
        asm volatile("s_waitcnt vmcnt(0)" ::: "memory"); SSD_BAR();
        if (c + 1 < 32) ssd_issue(lds, BNg, CNg, F.BT, F.XBC, b, g, h, c + 1, w, lane);
        const int lt = w >> 1, ptb = 2 * (w & 1);
        u32x2 zq[2];
#pragma unroll
        for (int i = 0; i < 2; ++i) zq[i] = *(const u32x2*)(F.Z + (size_t)(t0 + 16 * lt + fr) * DIN + h * 64 + 16 * (ptb + i) + 4 * fq);
        if (w == 0) {
            const float dtv = dt_next; float v = dtv * a_l2;
#pragma unroll
            for (int o = 1; o < 64; o <<= 1) { const float u = __shfl_up(v, o); if (lane >= o) v += u; }
            *(LAS float*)(lds + O_DT + lane * 4) = dtv; *(LAS float*)(lds + O_A2 + lane * 4) = v;
            if (c + 1 < 32) dt_next = F.DT[(size_t)(t0 + 64 + lane) * 32 + h];
        } else if (w == 1 && c > 0) {
            F.SS[(size_t)(t0 - 64 + lane) * 32 + h] = *(const LAS float*)(lds + O_SSP + lane * 4) + *(const LAS float*)(lds + O_SSP + 256 + lane * 4);
        }
#pragma unroll
        for (int pt = 0; pt < 4; ++pt) { const int p = 16 * pt + fr; u32x2 q; q.x = pk2(hacc[pt][0], hacc[pt][1]); q.y = pk2(hacc[pt][2], hacc[pt][3]);
            *(LAS u32x2*)(lds + O_HB + p * 256 + (((2 * w + (fq >> 1)) ^ (p & 15)) << 4) + (fq & 1) * 8) = q; }
        SSD_BAR();
        {
            const LAS unsigned char* raw = ib + O_RAW; float rv[11];
#pragma unroll
            for (int i = 0; i < 11; ++i) rv[i] = bf2f(*(const LAS bf16*)(raw + (8 * w + i) * 128 + lane * 2));
            if (c == 0 && w == 0) { rv[0] = 0.f; rv[1] = 0.f; rv[2] = 0.f; }
            const f32x4 d0 = *(const LAS f32x4*)(lds + O_DT + 32 * w), d1 = *(const LAS f32x4*)(lds + O_DT + 32 * w + 16);
            const f32x4 e0 = *(const LAS f32x4*)(lds + O_A2 + 32 * w), e1 = *(const LAS f32x4*)(lds + O_A2 + 32 * w + 16);
            const float a63 = *(const LAS float*)(lds + O_A2 + 63 * 4);
            f32x4 xa, xb, wa, wb;
#pragma unroll
            for (int i = 0; i < 8; ++i) { const float xc = siluf_(cbias + cw3 * rv[i + 3] + cw2 * rv[i + 2] + cw1 * rv[i + 1] + cw0 * rv[i]);
                const float dd = i < 4 ? d0[i] : d1[i - 4], aa = i < 4 ? e0[i] : e1[i - 4]; const float xd = xc * dd, xw = xd * __builtin_amdgcn_exp2f(a63 - aa);
                if (i < 4) { xa[i] = xd; wa[i] = xw; } else { xb[i - 4] = xd; wb[i - 4] = xw; } }
            const int so = lane * 128 + ((w ^ ((lane >> 1) & 7)) << 4);
            *(LAS u32x4*)(lds + O_XT + so) = pack8(xa, xb); *(LAS u32x4*)(lds + O_XWT + so) = pack8(wa, wb);
        }
        {
            const int l = 16 * lt + fr; const float a2l = *(const LAS float*)(lds + O_A2 + l * 4), ddl = dsk / *(const LAS float*)(lds + O_DT + l * 4);
#pragma unroll
            for (int i = 0; i < 2; ++i) { const int st = ptb + i; f32x4 cb = (f32x4){0.f, 0.f, 0.f, 0.f};
                if (st <= lt) {
#pragma unroll
                    for (int ks = 0; ks < 4; ++ks) cb = __builtin_amdgcn_mfma_f32_16x16x32_bf16(frag256(ib + O_BN, 16 * st + fr, 4 * ks + fq), frag256(ib + O_CN, l, 4 * ks + fq), cb, 0, 0, 0);
                    const f32x4 a2s = *(const LAS f32x4*)(lds + O_A2 + (16 * st + 4 * fq) * 4);
#pragma unroll
                    for (int r = 0; r < 4; ++r) { const int sx = 16 * st + 4 * fq + r; float m = cb[r] * __builtin_amdgcn_exp2f(a2l - a2s[r]); m = (l >= sx) ? m : 0.f; if (l == sx) m += ddl; cb[r] = m; }
                }
                u32x2 q; q.x = pk2(cb[0], cb[1]); q.y = pk2(cb[2], cb[3]);
                *(LAS u32x2*)(lds + O_MM + l * 128 + (((2 * st + (fq >> 1)) ^ ((l >> 1) & 7)) << 4) + (fq & 1) * 8) = q; }
        }
        SSD_BAR();
        {
            const int l = 16 * lt + fr; f32x4 ya[2] = {(f32x4){0.f, 0.f, 0.f, 0.f}, (f32x4){0.f, 0.f, 0.f, 0.f}};
#pragma unroll
            for (int ks = 0; ks < 4; ++ks) { const bf16x8 yf = frag256(ib + O_CN, l, 4 * ks + fq);
#pragma unroll
                for (int i = 0; i < 2; ++i) ya[i] = __builtin_amdgcn_mfma_f32_16x16x32_bf16(frag256(lds + O_HB, 16 * (ptb + i) + fr, 4 * ks + fq), yf, ya[i], 0, 0, 0); }
            const float el = __builtin_amdgcn_exp2f(*(const LAS float*)(lds + O_A2 + l * 4));
            ya[0] *= el; ya[1] *= el;
#pragma unroll
            for (int ks = 0; ks < 2; ++ks) if (32 * ks <= 16 * lt + 15) { const bf16x8 yf = frag128(lds + O_MM, l, 4 * ks + fq);
#pragma unroll
                for (int i = 0; i < 2; ++i) ya[i] = __builtin_amdgcn_mfma_f32_16x16x32_bf16(frag128(lds + O_XT, 16 * (ptb + i) + fr, 4 * ks + fq), yf, ya[i], 0, 0, 0); }
            float ssq = 0.f;
#pragma unroll
            for (int i = 0; i < 2; ++i) { const float z0 = bf2f(zq[i].x & 0xffffu), z1 = bf2f(zq[i].x >> 16), z2 = bf2f(zq[i].y & 0xffffu), z3 = bf2f(zq[i].y >> 16);
                const float v0 = ya[i][0] * z0, v1 = ya[i][1] * z1, v2 = ya[i][2] * z2, v3 = ya[i][3] * z3; ssq += (v0 * v0 + v1 * v1) + (v2 * v2 + v3 * v3);
                u32x2 q; q.x = pk2(v0, v1); q.y = pk2(v2, v3); *(u32x2*)(F.V + (size_t)(t0 + l) * DIN + h * 64 + 16 * (ptb + i) + 4 * fq) = q; }
            ssq += __shfl_xor(ssq, 16); ssq += __shfl_xor(ssq, 32);
            if (fq == 0) *(LAS float*)(lds + O_SSP + (w & 1) * 256 + l * 4) = ssq;
        }
        {
            const float ed = __builtin_amdgcn_exp2f(*(const LAS float*)(lds + O_A2 + 63 * 4));
#pragma unroll
            for (int pt = 0; pt < 4; ++pt) hacc[pt] *= ed;
#pragma unroll
            for (int ks = 0; ks < 2; ++ks) { const bf16x8 xf = frag128(ib + O_BT, 16 * w + fr, 4 * ks + fq);
#pragma unroll
                for (int pt = 0; pt < 4; ++pt) hacc[pt] = __builtin_amdgcn_mfma_f32_16x16x32_bf16(xf, frag128(lds + O_XWT, 16 * pt + fr, 4 * ks + fq), hacc[pt], 0, 0, 0); }
        }
    }
    SSD_BAR();
    if (w == 1) F.SS[(size_t)(b * SEQ + 31 * 64 + lane) * 32 + h] = *(const LAS float*)(lds + O_SSP + lane * 4) + *(const LAS float*)(lds + O_SSP + 256 + lane * 4);
    asm volatile("s_waitcnt vmcnt(0)" ::: "memory"); SSD_BAR();
}

__device__ __forceinline__ void p3_rstd(const Frame& F) {
#pragma unroll 1
    for (int t = F.wg * NTHREADS + F.tid; t < T; t += F.G * NTHREADS) { float r[4];
#pragma unroll
        for (int g = 0; g < 4; ++g) { float s = 0.f;
#pragma unroll
            for (int q = 0; q < 8; ++q) s += F.SS[(size_t)t * 32 + g * 8 + q];
            r[g] = rsqrtf(s * (1.f / 512.f) + EPS); }
        *(f32x4*)(F.RSTD + (size_t)t * 4) = (f32x4){r[0] / r[1], r[1] / r[2], r[2] / r[3], r[3]}; }
}
__device__ __forceinline__ void p6_router(const Frame& F) {
    LAS int* cnt = (LAS int*)(F.lds + O_W32_CNT);
    w32_fill(F, F.w_router, 32);
    if (F.tid < 32) cnt[F.tid] = 0;
    __syncthreads();
    const RouterOut O{(LAS float*)(F.lds + O_W32_SCR + F.wave * 128), cnt, F.b_router, F.TIDX, F.TW};
    w32_rows(F, F.out, F.ffn_norm_g, F.XN, O);
    __syncthreads();
    if (F.tid < 32) F.CNT[F.wg * 32 + F.tid] = cnt[F.tid];
}
__device__ __forceinline__ void p7_route(const Frame& F) {
    LAS int* base = (LAS int*)F.lds; LAS int* tot = base + 32; LAS int* pstart = tot + 32; LAS int* wcnt = pstart + 64;
    const int tid = F.tid, lane = F.lane;
    if (tid < 64) base[tid] = 0;
    __syncthreads();
    { const int e = tid & 31, w0 = 16 * (tid >> 5); int tt = 0, bb = 0;
#pragma unroll
      for (int i = 0; i < 16; ++i) { const int c = F.CNT[(w0 + i) * 32 + e]; tt += c; bb += (w0 + i < F.wg) ? c : 0; }
      __hip_atomic_fetch_add(tot + e, tt, __ATOMIC_RELAXED, __HIP_MEMORY_SCOPE_WORKGROUP); __hip_atomic_fetch_add(base + e, bb, __ATOMIC_RELAXED, __HIP_MEMORY_SCOPE_WORKGROUP); }
    int e_mine = 0, lr = 0;
    if (tid < 256) {
        e_mine = F.TIDX[F.wg * 256 + tid];
        const unsigned long long lt_mask = (1ull << lane) - 1ull;
#pragma unroll 1
        for (int q = 0; q < 32; ++q) { const unsigned long long m = __ballot(e_mine == q); if (e_mine == q) lr = __popcll(m & lt_mask); if (lane == 0) wcnt[F.wave * 32 + q] = __popcll(m); }
    }
    __syncthreads();
    if (tid == 0) { int sacc = 0;
#pragma unroll 1
        for (int e = 0; e < 32; ++e) { pstart[e] = sacc; sacc += (tot[e] + 255) / 256 * 256; } pstart[32] = sacc; }
    __syncthreads();
    if (tid < 256) { int off = 0;
#pragma unroll
        for (int w = 0; w < 3; ++w) off += (w < F.wave) ? wcnt[w * 32 + e_mine] : 0;
        const int d = pstart[e_mine] + base[e_mine] + off + lr; F.DEST[F.wg * 256 + tid] = d; F.ROWTOK[d] = F.wg * 64 + (tid >> 2); }
    if (F.wg < 32) { const int e = F.wg;
#pragma unroll 1
        for (int r = pstart[e] + tot[e] + tid; r < pstart[e + 1]; r += NTHREADS) F.ROWTOK[r] = 0; }
    if (F.wg == 0 && tid < 33) F.PSTART[tid] = pstart[tid];
    if (F.wg == 0 && tid < MAXROWS / 256) { int e = 0;
#pragma unroll 1
        for (int q = 1; q < 32; ++q) if (tid * 256 >= pstart[q]) e = q;
        F.TILE_E[tid] = e; }
}
__device__ __forceinline__ int expert_of_row(const int* ps, int row) { int e = 0;
#pragma unroll 1
    for (int q = 1; q < 32; ++q) if (row >= ps[q]) e = q;
    return e; }
__device__ __forceinline__ void p8_moe_gu(const Frame& F) {
    const int nrt = F.PSTART[32] / 256; const EpiGU E{F.ACT, F.b_gate_up}; const NoHook H;
#pragma unroll 1
    for (int ui = F.wg; ui < nrt * 8; ui += F.G) { GUnit u; u.pm = ui >> 3; u.pn = ui & 7; u.e = expert_of_row(F.PSTART, u.pm * 256); u.a = F.XN; u.bt = F.WGU + (size_t)u.e * 2048 * 1024;
        sgemm_unit(u, 1024, 1024, F.ROWTOK, E, H, F.wave, F.lane); }
}
__device__ __forceinline__ void p9_moe_dn(const Frame& F) {
    const int nrt = F.PSTART[32] / 256; const EpiDN E{F.YR, F.b_down}; const NoHook H;
#pragma unroll 1
    for (int ui = F.wg; ui < nrt * 4; ui += F.G) { GUnit u; u.pm = ui >> 2; u.pn = ui & 3; u.e = expert_of_row(F.PSTART, u.pm * 256); u.a = F.ACT; u.bt = F.WDN + (size_t)u.e * 1024 * 1024;
        sgemm_unit(u, 1024, 1024, nullptr, E, H, F.wave, F.lane); }
}
__device__ __forceinline__ void p10_combine(const Frame& F) {
    const int gw = F.wg * NWAVES + F.wave, NGW = F.G * NWAVES, lane = F.lane;
#pragma unroll 1
    for (int row = gw; row < T; row += NGW) {
        f32x4* xr = (f32x4*)(F.out + (size_t)row * D) + lane;
        f32x4 v[4];
#pragma unroll
        for (int j = 0; j < 4; ++j) v[j] = xr[64 * j];
#pragma unroll
        for (int k = 0; k < 4; ++k) { const int d = F.DEST[row * 4 + k]; const float w = F.TW[row * 4 + k]; const u32x2* yr = (const u32x2*)(F.YR + (size_t)d * 1024) + lane;
#pragma unroll
            for (int j = 0; j < 4; ++j) { const u32x2 q = yr[64 * j]; v[j][0] += w * bf2f(q.x & 0xffffu); v[j][1] += w * bf2f(q.x >> 16); v[j][2] += w * bf2f(q.y & 0xffffu); v[j][3] += w * bf2f(q.y >> 16); } }
        float s = 0.f;
#pragma unroll
        for (int j = 0; j < 4; ++j) { xr[64 * j] = v[j]; s += (v[j][0] * v[j][0] + v[j][1] * v[j][1]) + (v[j][2] * v[j][2] + v[j][3] * v[j][3]); }
        const float rs = rsqrtf(wave_sum(s) * (1.f / D) + EPS);
        u32x2* o8 = (u32x2*)(F.XN + (size_t)row * D) + lane;
#pragma unroll
        for (int j = 0; j < 4; ++j) { const f32x4 g = ((const f32x4*)F.ple_norm_g)[lane + 64 * j]; const f32x4 q = v[j] * rs * g; u32x2 w; w.x = pk2(q[0], q[1]); w.y = pk2(q[2], q[3]); o8[64 * j] = w; }
    }
}
__device__ __forceinline__ void p12_final(const Frame& F) {
    const int gw = F.wg * NWAVES + F.wave, NGW = F.G * NWAVES, lane = F.lane;
#pragma unroll 1
    for (int row = gw; row < T; row += NGW) {
        f32x4* xr = (f32x4*)(F.out + (size_t)row * D) + lane; f32x4 v[4]; float s = 0.f;
#pragma unroll
        for (int j = 0; j < 4; ++j) { v[j] = xr[64 * j]; s += (v[j][0] * v[j][0] + v[j][1] * v[j][1]) + (v[j][2] * v[j][2] + v[j][3] * v[j][3]); }
        const float rs = rsqrtf(wave_sum(s) * (1.f / D) + EPS);
#pragma unroll
        for (int j = 0; j < 4; ++j) { const f32x4 g = ((const f32x4*)F.final_norm_g)[lane + 64 * j]; xr[64 * j] = v[j] * rs * g; }
    }
}

constexpr int LDS_BYTES = 163840;
constexpr int MISC_OFF = 162816;

__global__ void __launch_bounds__(NTHREADS, 2) mk_fwd(Args args) {
    extern __shared__ __attribute__((aligned(16))) unsigned char lds_raw[];
    Frame F;
    F.lds = (LAS unsigned char*)lds_raw; F.tid = threadIdx.x; F.lane = F.tid & 63; F.wave = __builtin_amdgcn_readfirstlane(F.tid >> 6); F.G = gridDim.x; F.wg = blockIdx.x;
    unsigned char* ws = args.ws;
    F.x = args.in[0]; F.p = args.in[1]; F.mix_norm_g = args.in[2]; F.w_in = args.in[3]; F.conv_w = args.in[4]; F.conv_b = args.in[5]; F.dt_bias = args.in[6]; F.a_log = args.in[7]; F.d_skip = args.in[8];
    F.ssd_norm_g = args.in[9]; F.w_ssd_out = args.in[10]; F.pool_w = args.in[11]; F.pool_scale = args.in[12]; F.w_mix_out = args.in[13]; F.ffn_norm_g = args.in[14]; F.w_router = args.in[15];
    F.b_router = args.in[16]; F.w_gate_up = args.in[17]; F.b_gate_up = args.in[18]; F.w_down = args.in[19]; F.b_down = args.in[20]; F.ple_norm_g = args.in[21]; F.w_ple_gate = args.in[22];
    F.w_ple_proj = args.in[23]; F.final_norm_g = args.in[24]; F.out = args.out;
    F.WIN = (bf16*)(ws + WS_WIN); F.WOUT = (bf16*)(ws + WS_WOUT); F.WPOOL = (bf16*)(ws + WS_WPOOL); F.WMIX = (bf16*)(ws + WS_WMIX); F.WPG = (bf16*)(ws + WS_WPG); F.WPP = (bf16*)(ws + WS_WPP);
    F.WGU = (bf16*)(ws + WS_WGU); F.WDN = (bf16*)(ws + WS_WDN); F.XN = (bf16*)(ws + WS_XN); F.PO = (bf16*)(ws + WS_PO); F.YPG = (bf16*)(ws + WS_YPG); F.MIXED = (bf16*)(ws + WS_MIXED);
    F.PB = (bf16*)(ws + WS_PB); F.Z = (bf16*)(ws + WS_Z); F.XBC = (bf16*)(ws + WS_XBC); F.U = (bf16*)(ws + WS_U); F.GT = (bf16*)(ws + WS_GT); F.V = (bf16*)(ws + WS_V);
    F.ACT = (bf16*)(ws + WS_ACT); F.YR = (bf16*)(ws + WS_YR); F.DT = (float*)(ws + WS_DT); F.SS = (float*)(ws + WS_SS); F.RSTD = (float*)(ws + WS_RSTD); F.TMP = (float*)(ws + WS_TMP); F.BN = (bf16*)(ws + WS_BN); F.CN = (bf16*)(ws + WS_CN); F.BT = (bf16*)(ws + WS_BT);
    { unsigned char* r = ws + WS_ROUTE; F.TIDX = (int*)r; r += NA * 4; F.TW = (float*)r; r += NA * 4; F.DEST = (int*)r; r += NA * 4; F.ROWTOK = (int*)r; r += MAXROWS * 4; F.CNT = (int*)r; r += 256 * 32 * 4; F.PSTART = (int*)r; r += 256; F.TILE_E = (int*)r; }

    volatile LAS unsigned* MISC = (volatile LAS unsigned*)(F.lds + MISC_OFF);
    if (F.tid < 64) MISC[F.tid] = 0u;
    __syncthreads();
    const int lo = args.ph_lo, hi = args.ph_hi;
    XcdBarrier bar; bar.bar = (unsigned*)(ws + WS_CTL) + CW_BAR; bar.x = 0; bar.st = nullptr;
    if (hi - lo > 1) bar = xcd_barrier_post((unsigned*)(ws + WS_CTL) + CW_BAR, MISC + 8);
#define IN(k) (lo <= (k) && (k) < hi)
#define SEAM(k) do { if (IN(k) && IN((k) + 1)) xcd_barrier(bar); } while (0)
    const NoHook NH_; const NoHookPg NHP;
    LAS unsigned char* ring = F.lds;
#define PG(k) ((PGMASK >> (k)) & 1)
    if (IN(0)) for (int _r = 0; _r < (REP_PH == 0 ? 2 : 1); ++_r) { if (_r) xcd_barrier(bar); p0_prologue(F); p0_rows(F); } SEAM(0);
    if (IN(1)) for (int _r = 0; _r < (REP_PH == 1 ? 2 : 1); ++_r) { if (_r) xcd_barrier(bar); const EpiInproj E{F.Z, F.XBC, F.U, F.GT};
        if (PG(1)) { const DenseOrder S{64, 32, 64 * 32, F.G, F.wg, F.XN, F.WIN}; pg::gemm_phase<EpiInproj, DenseOrder, NoHookPg, true, false>(ring, 1024, 1024, nullptr, S, E, NHP); }
        else dense_gemm_phase(F, F.XN, 1024, F.WIN, 1024, 64, 32, E, NH_); } SEAM(1);
    if (IN(2)) for (int _r = 0; _r < (REP_PH == 2 ? 2 : 1); ++_r) { if (_r) xcd_barrier(bar); p2a_conv_bc(F); p2_pool(F); } SEAM(2);
    if (IN(3)) for (int _r = 0; _r < (REP_PH == 3 ? 2 : 1); ++_r) { if (_r) xcd_barrier(bar); if (SSD_FAST) p2b_ssd(F); else p2_ssd_naive(F); } SEAM(3);
    if (IN(4)) for (int _r = 0; _r < (REP_PH == 4 ? 2 : 1); ++_r) { if (_r) xcd_barrier(bar); p3_rstd(F); const EpiPool E{F.YPG, F.GT};
        if (PG(4)) { __syncthreads(); const PoolOrder S{F.G, F.wg, F.PO, F.WPOOL}; pg::gemm_phase<EpiPool, PoolOrder, NoHookPg, false, false>(ring, 1024, 256, nullptr, S, E, NHP); }
        else {
#pragma unroll 1
        for (int ui = F.wg; ui < 64 * 4; ui += F.G) { GUnit u; u.pm = ui >> 2; u.pn = 0; u.e = ui & 3; u.a = F.PO + 256 * u.e; u.bt = F.WPOOL + (size_t)u.e * 65536; sgemm_unit(u, 1024, 256, nullptr, E, NH_, F.wave, F.lane); } } } SEAM(4);
    if (IN(5)) for (int _r = 0; _r < (REP_PH == 5 ? 2 : 1); ++_r) { if (_r) xcd_barrier(bar); const EpiOut E{F.MIXED, F.GT, F.YPG};
        if (PG(5)) { const DenseOrder S{64, 4, 256, F.G, F.wg, F.V, F.WOUT}; GUnit u0; LAS float* tab = (LAS float*)(F.lds + 131072 + 1024);
            if (S.next(0, u0) && F.tid < 256) { const f32x4 r = *(const f32x4*)(F.RSTD + (size_t)(u0.pm * 256 + F.tid) * 4); *(LAS f32x4*)(tab + F.tid * 4) = r; }
            __syncthreads();
            const RatioHook H{tab}; pg::gemm_phase<EpiOut, DenseOrder, RatioHook, false, false>(ring, 2048, 2048, nullptr, S, E, H); }
        else { const RstdHook H{F.RSTD}; dense_gemm_phase(F, F.V, 2048, F.WOUT, 2048, 64, 4, E, H); } } SEAM(5);
    if (IN(6)) for (int _r = 0; _r < (REP_PH == 6 ? 2 : 1); ++_r) { if (_r) xcd_barrier(bar); const EpiMix E{F.x, F.out};
        if (PG(6)) { const DenseOrder S{64, 4, 256, F.G, F.wg, F.MIXED, F.WMIX}; pg::gemm_phase<EpiMix, DenseOrder, NoHookPg, false, false>(ring, 1024, 1024, nullptr, S, E, NHP); }
        else dense_gemm_phase(F, F.MIXED, 1024, F.WMIX, 1024, 64, 4, E, NH_); } SEAM(6);
    if (IN(7)) for (int _r = 0; _r < (REP_PH == 7 ? 2 : 1); ++_r) { if (_r) xcd_barrier(bar); p6_router(F); } SEAM(7);
    if (IN(8)) for (int _r = 0; _r < (REP_PH == 8 ? 2 : 1); ++_r) { if (_r) xcd_barrier(bar); p7_route(F); } SEAM(8);
    if (IN(9)) for (int _r = 0; _r < (REP_PH == 9 ? 2 : 1); ++_r) { if (_r) xcd_barrier(bar); if (PG(9)) { const EpiGU E{F.ACT, F.b_gate_up}; const MoeOrder<8, 2048> S{F.G, F.wg, F.PSTART[32] / 256, F.TILE_E, F.XN, F.WGU};
            pg::gemm_phase<EpiGU, MoeOrder<8, 2048>, NoHookPg, true, true>(ring, 1024, 1024, F.ROWTOK, S, E, NHP); }
        else p8_moe_gu(F); } SEAM(9);
    if (IN(10)) for (int _r = 0; _r < (REP_PH == 10 ? 2 : 1); ++_r) { if (_r) xcd_barrier(bar); if (PG(10)) { const EpiDN E{F.YR, F.b_down}; const MoeOrder<4, 1024> S{F.G, F.wg, F.PSTART[32] / 256, F.TILE_E, F.ACT, F.WDN};
            pg::gemm_phase<EpiDN, MoeOrder<4, 1024>, NoHookPg, true, false>(ring, 1024, 1024, nullptr, S, E, NHP); }
        else p9_moe_dn(F); } SEAM(10);
    if (IN(11)) for (int _r = 0; _r < (REP_PH == 11 ? 2 : 1); ++_r) { if (_r) xcd_barrier(bar); p10_combine(F); } SEAM(11);
    if (IN(12)) for (int _r = 0; _r < (REP_PH == 12 ? 2 : 1); ++_r) { if (_r) xcd_barrier(bar); const EpiF32 E1{F.TMP}; const EpiPle E2{F.TMP, F.out};
        if (PG(12)) { const DenseOrder S1{64, 4, 256, F.G, F.wg, F.PB, F.WPP}; pg::gemm_phase<EpiF32, DenseOrder, NoHookPg, false, false>(ring, 256, 256, nullptr, S1, E1, NHP);
            asm volatile("s_waitcnt vmcnt(0)" ::: "memory"); __syncthreads();
            const DenseOrder S2{64, 4, 256, F.G, F.wg, F.XN, F.WPG}; pg::gemm_phase<EpiPle, DenseOrder, NoHookPg, false, false>(ring, 1024, 1024, nullptr, S2, E2, NHP); }
        else {
#pragma unroll 1
        for (int ui = F.wg; ui < 64 * 4; ui += F.G) { GUnit u; u.pm = ui >> 2; u.pn = ui & 3; u.e = 0; u.a = F.PB; u.bt = F.WPP; sgemm_unit(u, 256, 256, nullptr, E1, NH_, F.wave, F.lane);
            asm volatile("s_waitcnt vmcnt(0)" ::: "memory"); __syncthreads();
            u.a = F.XN; u.bt = F.WPG; sgemm_unit(u, 1024, 1024, nullptr, E2, NH_, F.wave, F.lane); } } } SEAM(12);
    if (IN(13)) for (int _r = 0; _r < (REP_PH == 13 ? 2 : 1); ++_r) { if (_r) xcd_barrier(bar); p12_final(F); }
#undef PG
#undef IN
#undef SEAM
}
}

extern "C" void kernel_launch(void* const* d_in, const int* in_sizes, int n_in, void* d_out, int out_size, void* d_ws, size_t ws_size, hipStream_t stream) {
    static int grid = 0;
    if (grid == 0) {
        if (n_in != 25 || in_sizes[0] != T * D || out_size != T * D || ws_size < WS_END) { fprintf(stderr, "kernel_launch: unexpected shapes (n_in %d, out %d, ws %zu)\n", n_in, out_size, ws_size); grid = -1; return; }
        int dev = 0, cus = 0, per_cu = 0;
        if (hipGetDevice(&dev) != hipSuccess || hipDeviceGetAttribute(&cus, hipDeviceAttributeMultiprocessorCount, dev) != hipSuccess) { grid = -1; return; }
        if (hipFuncSetAttribute((const void*)mk_fwd, hipFuncAttributeMaxDynamicSharedMemorySize, LDS_BYTES) != hipSuccess) { fprintf(stderr, "kernel_launch: hipFuncSetAttribute failed\n"); grid = -1; return; }
        if (hipOccupancyMaxActiveBlocksPerMultiprocessor(&per_cu, (const void*)mk_fwd, NTHREADS, LDS_BYTES) != hipSuccess || per_cu < 1) { fprintf(stderr, "kernel_launch: occupancy query says %d blocks/CU\n", per_cu); (void)hipGetLastError(); grid = -1; return; }
        grid = cus;
        if (grid != 256) { fprintf(stderr, "kernel_launch: built for a 256-CU device, found %d CUs\n", cus); grid = -1; return; }
    }
    if (grid < 0) return;
    (void)hipMemsetAsync((char*)d_ws + WS_CTL, 0, CTL_ZERO_BYTES, stream);
    Args a; memset(&a, 0, sizeof(a));
    for (int i = 0; i < 25; ++i) a.in[i] = (const float*)d_in[i];
    a.out = (float*)d_out; a.ws = (unsigned char*)d_ws;
#if MK_MULTI
    for (int ph = 0; ph < NPH; ++ph) { a.ph_lo = ph; a.ph_hi = ph + 1; hipLaunchKernelGGL(mk_fwd, dim3(grid), dim3(NTHREADS), LDS_BYTES, stream, a); }
#else
    a.ph_lo = 0; a.ph_hi = NPH;
    void* kargs[] = {&a};
    hipError_t e = hipLaunchCooperativeKernel((const void*)mk_fwd, dim3(grid), dim3(NTHREADS), kargs, LDS_BYTES, stream);
    if (e != hipSuccess) fprintf(stderr, "kernel_launch: cooperative launch failed: %s\n", hipGetErrorString(e));
#endif
}
```
